# Optimizing an MI355X kernel written in HIP

```python
import jax, jax.numpy as jnp
from jax import lax
import numpy as np

D_MODEL = 1024
BATCH = 8
SEQ = 4096
DEPTH = 4

N_MIXERS = 2
N_POOL_LAYERS = (DEPTH + 1) // 2
N_GLA_LAYERS = DEPTH // 2
POOL_WINDOWS = (2, 4, 8, 16)
POOL_GROUPS = len(POOL_WINDOWS)
POOL_GROUP_DIM = D_MODEL // POOL_GROUPS
GLA_HEADS = 4
GLA_KEY_DIM = D_MODEL // 2
GLA_VALUE_DIM = D_MODEL
GLA_HEAD_K = GLA_KEY_DIM // GLA_HEADS
GLA_HEAD_V = GLA_VALUE_DIM // GLA_HEADS
GLA_GATE_RANK = 16
GLA_GATE_TEMP = 16.0
GLA_CHUNK = 64
GLA_IN_DIM = 2 * GLA_KEY_DIM + 2 * GLA_VALUE_DIM + GLA_GATE_RANK
MOE_GROUPS = 8
MOE_EXPERTS_PER_GROUP = 8
MOE_EXPERTS = MOE_GROUPS * MOE_EXPERTS_PER_GROUP
MOE_TOP_E = 2
MOE_D_FF = 384
NORM_EPS = 1e-6

kernel_name = "hybrid_pool_gla_hiermoe_adaln"


def rmsnorm(x, g):
    xf = x.astype(jnp.float32)
    y = xf * lax.rsqrt(jnp.mean(xf * xf, axis=-1, keepdims=True) + NORM_EPS)
    return (y * g.astype(jnp.float32)).astype(x.dtype)


def pool_mixer(h, w, b, scale):
    B, S, _ = h.shape
    hf = h.astype(jnp.float32).reshape(B, S, POOL_GROUPS, POOL_GROUP_DIM)
    cs = jnp.cumsum(hf, axis=1)
    pos = jnp.arange(1, S + 1, dtype=jnp.float32)
    outs = []
    for gi, win in enumerate(POOL_WINDOWS):
        csg = cs[:, :, gi]
        lag = jnp.pad(csg, ((0, 0), (win, 0), (0, 0)))[:, :S]
        mean = (csg - lag) / jnp.minimum(pos, float(win))[None, :, None]
        outs.append(mean - hf[:, :, gi])
    d = jnp.stack(outs, axis=2).astype(h.dtype)
    y = jnp.einsum('bsgc,gcd->bsgd', d, w).reshape(B, S, D_MODEL) + b
    return y * scale


def gla_mixer(h, w_in, w_gate, b_gate, norm_g, w_out):
    B, S, _ = h.shape
    C = GLA_CHUNK
    N = S // C
    proj = h @ w_in
    q, k, v, r, z = jnp.split(
        proj, [GLA_KEY_DIM, 2 * GLA_KEY_DIM, 2 * GLA_KEY_DIM + GLA_VALUE_DIM,
               2 * GLA_KEY_DIM + 2 * GLA_VALUE_DIM], axis=-1)
    g = jax.nn.log_sigmoid((z @ w_gate + b_gate).astype(jnp.float32)) / GLA_GATE_TEMP

    def to_chunks(t, dh):
        return t.astype(jnp.float32).reshape(B, N, C, GLA_HEADS, dh).transpose(0, 3, 1, 2, 4)

    qc = to_chunks(q, GLA_HEAD_K) * (GLA_HEAD_K ** -0.5)
    kc = to_chunks(k, GLA_HEAD_K)
    vc = to_chunks(v, GLA_HEAD_V)
    gc = to_chunks(g, GLA_HEAD_K)
    bcum = jnp.cumsum(gc, axis=3)
    b_last = bcum[:, :, :, -1:, :]
    q_e = qc * jnp.exp(bcum)
    k_e = kc * jnp.exp(-bcum)
    k_dec = kc * jnp.exp(b_last - bcum)
    causal = jnp.tril(jnp.ones((C, C), dtype=bool))
    scores = jnp.where(causal, jnp.einsum('bhnid,bhnjd->bhnij', q_e, k_e), 0.0)
    o_intra = jnp.einsum('bhnij,bhnjv->bhniv', scores, vc)

    def step(state, inp):
        q_n, k_n, v_n, decay_n = inp
        o_n = jnp.einsum('bhid,bhdv->bhiv', q_n, state)
        state = decay_n[..., None] * state + jnp.einsum('bhjd,bhjv->bhdv', k_n, v_n)
        return state, o_n

    xs = (jnp.moveaxis(q_e, 2, 0), jnp.moveaxis(k_dec, 2, 0), jnp.moveaxis(vc, 2, 0),
          jnp.moveaxis(jnp.exp(b_last[:, :, :, 0, :]), 2, 0))
    s0 = jnp.zeros((B, GLA_HEADS, GLA_HEAD_K, GLA_HEAD_V), jnp.float32)
    _, o_inter = lax.scan(step, s0, xs)
    o = o_intra + jnp.moveaxis(o_inter, 0, 2)
    o = o * lax.rsqrt(jnp.mean(o * o, axis=-1, keepdims=True) + NORM_EPS) * norm_g.astype(jnp.float32)
    o = o.transpose(0, 2, 3, 1, 4).reshape(B, S, GLA_VALUE_DIM).astype(h.dtype)
    o = o * jax.nn.silu(r)
    return o @ w_out


def hier_moe(h, w_group, b_group, w_expert, b_expert, w_in, w_out):
    B, S, D = h.shape
    t = h.reshape(-1, D)
    T = t.shape[0]
    p_group = jax.nn.softmax((t @ w_group + b_group).astype(jnp.float32), axis=-1)
    p_g, g_idx = lax.top_k(p_group, 1)
    logits_e = (t @ w_expert + b_expert).astype(jnp.float32).reshape(T, MOE_GROUPS, MOE_EXPERTS_PER_GROUP)
    logits_sel = jnp.take_along_axis(logits_e, g_idx[:, :, None], axis=1)[:, 0]
    p_e = jax.nn.softmax(logits_sel, axis=-1)
    p_top, e_idx = lax.top_k(p_e, MOE_TOP_E)
    weights = p_g * p_top / jnp.sum(p_top, axis=-1, keepdims=True)
    flat_id = (g_idx * MOE_EXPERTS_PER_GROUP + e_idx).reshape(-1)
    order = jnp.argsort(flat_id)
    token_of = order // MOE_TOP_E
    xs = t[token_of]
    group_sizes = jnp.bincount(flat_id, length=MOE_EXPERTS).astype(jnp.int32)
    gu = lax.ragged_dot(xs, w_in, group_sizes)
    gate, up = jnp.split(gu, 2, axis=-1)
    ys = lax.ragged_dot(jax.nn.silu(gate) * up, w_out, group_sizes)
    ys = ys * weights.reshape(-1)[order][:, None].astype(ys.dtype)
    out = jnp.zeros_like(t).at[token_of].add(ys)
    return out.reshape(B, S, D)


def setup_inputs(seed: int = 0) -> dict:
    key = jax.random.key(seed)
    ks = jax.random.split(key, 22)
    D = D_MODEL
    f32 = jnp.float32
    nrm = lambda k, shape, s: jax.random.normal(k, shape, f32) * s
    return {
        "x": nrm(ks[0], (BATCH, SEQ, D), 1.0),
        "c": nrm(ks[1], (BATCH, D), 1.0),
        "norm_gain": 1.0 + nrm(ks[2], (DEPTH, 2, D), 0.1),
        "w_mod": nrm(ks[3], (DEPTH, D, 6 * D), 0.5 * D ** -0.5),
        "b_mod": nrm(ks[4], (DEPTH, 6 * D), 0.02),
        "pool_w": nrm(ks[5], (N_POOL_LAYERS, POOL_GROUPS, POOL_GROUP_DIM, POOL_GROUP_DIM), POOL_GROUP_DIM ** -0.5),
        "pool_b": nrm(ks[6], (N_POOL_LAYERS, D), 0.02),
        "pool_scale": 1.0 + nrm(ks[7], (N_POOL_LAYERS, D), 0.1),
        "gla_w_in": nrm(ks[8], (N_GLA_LAYERS, D, GLA_IN_DIM), D ** -0.5),
        "gla_w_gate": nrm(ks[9], (N_GLA_LAYERS, GLA_GATE_RANK, GLA_KEY_DIM), GLA_GATE_RANK ** -0.5),
        "gla_b_gate": nrm(ks[10], (N_GLA_LAYERS, GLA_KEY_DIM), 0.1),
        "gla_norm_g": 1.0 + nrm(ks[11], (N_GLA_LAYERS, GLA_HEAD_V), 0.1),
        "gla_w_out": nrm(ks[12], (N_GLA_LAYERS, GLA_VALUE_DIM, D), GLA_VALUE_DIM ** -0.5),
        "moe_w_group": nrm(ks[13], (DEPTH, D, MOE_GROUPS), D ** -0.5),
        "moe_b_group": nrm(ks[14], (DEPTH, MOE_GROUPS), 0.01),
        "moe_w_expert": nrm(ks[15], (DEPTH, D, MOE_EXPERTS), D ** -0.5),
        "moe_b_expert": nrm(ks[16], (DEPTH, MOE_EXPERTS), 0.01),
        "moe_w_in": nrm(ks[17], (DEPTH, MOE_EXPERTS, D, 2 * MOE_D_FF), D ** -0.5),
        "moe_w_out": nrm(ks[18], (DEPTH, MOE_EXPERTS, MOE_D_FF, D), MOE_D_FF ** -0.5),
        "final_norm_g": 1.0 + nrm(ks[19], (D,), 0.1),
    }


def reference(x, c, norm_gain, w_mod, b_mod, pool_w, pool_b, pool_scale,
              gla_w_in, gla_w_gate, gla_b_gate, gla_norm_g, gla_w_out,
              moe_w_group, moe_b_group, moe_w_expert, moe_b_expert, moe_w_in, moe_w_out,
              final_norm_g):
    for i in range(DEPTH):
        mod = (jax.nn.silu(c) @ w_mod[i] + b_mod[i])[:, None, :]
        shift1, scale1, gate1, shift2, scale2, gate2 = jnp.split(mod, 6, axis=-1)
        h = rmsnorm(x, norm_gain[i, 0]) * (1.0 + scale1) + shift1
        j = i // N_MIXERS
        if i % N_MIXERS == 0:
            y = pool_mixer(h, pool_w[j], pool_b[j], pool_scale[j])
        else:
            y = gla_mixer(h, gla_w_in[j], gla_w_gate[j], gla_b_gate[j], gla_norm_g[j], gla_w_out[j])
        x = x + gate1 * y
        h = rmsnorm(x, norm_gain[i, 1]) * (1.0 + scale2) + shift2
        x = x + gate2 * hier_moe(h, moe_w_group[i], moe_b_group[i], moe_w_expert[i], moe_b_expert[i],
                                 moe_w_in[i], moe_w_out[i])
    return rmsnorm(x, final_norm_g)
```

```cpp
#include <hip/hip_runtime.h>
#include <cstdio>
#include <cstdint>

#ifndef M1_FP8
#define M1_FP8 1
#endif
#ifndef G2_VR8
#define G2_VR8 0
#endif
#ifndef G2_FP8
#define G2_FP8 0
#endif
#ifndef Y_FP8
#define Y_FP8 1
#endif
#ifndef G5_FP8
#define G5_FP8 1
#endif
#ifndef M2_FP8
#define M2_FP8 1
#endif
#ifndef FUSE_RES
#define FUSE_RES 1
#endif
#ifndef FUSE_G4
#define FUSE_G4 1
#endif
#ifndef XB_BF16
#define XB_BF16 1
#endif
#ifndef ROUTER_SPLIT
#define ROUTER_SPLIT 0
#endif
#ifndef MK_ONE_LAUNCH
#define MK_ONE_LAUNCH 1
#endif

#define LAS __attribute__((address_space(3)))
#define GAS __attribute__((address_space(1)))
typedef unsigned short bf16_t;
typedef short bf16x8 __attribute__((ext_vector_type(8)));
typedef float f32x4 __attribute__((ext_vector_type(4)));
typedef float f32x2 __attribute__((ext_vector_type(2)));
typedef unsigned u32x4 __attribute__((ext_vector_type(4)));
typedef unsigned u32x2 __attribute__((ext_vector_type(2)));

constexpr int NB = 8, SEQ = 4096, D = 1024, T = NB * SEQ, DEPTH = 4;
constexpr int GIN = 3088, NPROJ = 3072, GK = 512, HK = 128, HV = 256, NH = 4, CH = 64, NCH = SEQ / CH;
constexpr int NE = 64, FF = 384, NRT = 80;
constexpr float EPS = 1e-6f;
constexpr int NWAVES = 8, NTHR = 512;
constexpr int LISTCAP = 65536 + 256;

constexpr size_t MiB = 1u << 20;
constexpr size_t WS_CTL = 0, CTL_ZERO_BYTES = 65536;
constexpr size_t WS_MOD = 1 * MiB;
constexpr size_t WS_PAR = 1 * MiB + 786432;
constexpr int PAR_NG = 0, PAR_PB = 8192, PAR_PS = 10240, PAR_GWG = 12288, PAR_GBG = 28672, PAR_GNG = 29696, PAR_MBG = 30208, PAR_MBE = 30240, PAR_FNG = 30496, PAR_END = 31520;
constexpr size_t WS_WR = 2 * MiB;
constexpr size_t WS_WZ = 4 * MiB;
constexpr size_t WS_WPL = 5 * MiB;
constexpr size_t WS_WGO = 6 * MiB;
constexpr size_t WS_WGI = 10 * MiB;
constexpr size_t WS_WMO = 22 * MiB;
constexpr size_t WS_WMI = 214 * MiB;
constexpr size_t WS_X = 598 * MiB;
constexpr size_t WS_H = 726 * MiB;
constexpr size_t WS_U = 790 * MiB;
constexpr size_t WS_Y = 854 * MiB;
constexpr size_t WS_PROJ = 982 * MiB;
constexpr size_t WS_Z = 1174 * MiB;
constexpr size_t WS_FRAG = 1176 * MiB;
constexpr int FRAG_P = 0, FRAG_Q = 8192, FRAG_K = 24576, FRAG_D = 40960, FRAG_ITEM = 41472;
constexpr size_t WS_QE = 1176 * MiB;
constexpr size_t WS_KDT = 1208 * MiB;
constexpr size_t WS_PB = 1240 * MiB;
constexpr size_t WS_DEC = 1256 * MiB;
constexpr size_t WS_O = 1257 * MiB;
constexpr size_t WS_A = 1321 * MiB;
constexpr size_t WS_ACT = 1385 * MiB;
constexpr size_t WS_LIST = 1449 * MiB;
constexpr size_t WS_END = 1484 * MiB;
constexpr size_t WS_X2 = 1484 * MiB;
constexpr size_t WS_END2 = 1612 * MiB;
constexpr size_t WS_DRY = 1100 * MiB;
constexpr int CW_BAR = 4096;
constexpr int CW_CNT = 8192;
static_assert((CW_CNT + DEPTH * 64 * 16) * 4 <= (int)CTL_ZERO_BYTES, "control words inside the per-call memset");

constexpr int LDS_BYTES = 147456;
constexpr int L_STAGE = 0;
constexpr int L_IDX = 131072;
constexpr int L_UT = 131072 + 6144;
constexpr int L_ECNT = L_UT + 256;
constexpr int L_ETB = L_ECNT + 256;
constexpr int L_TT = L_ETB + 256;
constexpr int L_MISC = LDS_BYTES - 256;

typedef __bf16 bf16x2_t __attribute__((ext_vector_type(2)));
__device__ __forceinline__ unsigned pk2(float lo, float hi) { const bf16x2_t v = __builtin_convertvector((f32x2){lo, hi}, bf16x2_t); return __builtin_bit_cast(unsigned, v); }
__device__ __forceinline__ unsigned f2bf(float f) { return pk2(f, 0.f) & 0xffffu; }
__device__ __forceinline__ float bf2f(unsigned b) { return __builtin_bit_cast(float, b << 16); }
__device__ __forceinline__ float bflo(unsigned w) { return __builtin_bit_cast(float, w << 16); }
__device__ __forceinline__ float bfhi(unsigned w) { return __builtin_bit_cast(float, w & 0xffff0000u); }
template <int CTRL> __device__ __forceinline__ float dpp_f(float v) { return __builtin_bit_cast(float, __builtin_amdgcn_mov_dpp(__builtin_bit_cast(int, v), CTRL, 0xf, 0xf, true)); }
__device__ __forceinline__ float xsum16(float v) { const unsigned u = __builtin_bit_cast(unsigned, v); const auto r = __builtin_amdgcn_permlane16_swap(u, u, false, false); return __builtin_bit_cast(float, (unsigned)r[0]) + __builtin_bit_cast(float, (unsigned)r[1]); }
__device__ __forceinline__ float xsum32(float v) { const unsigned u = __builtin_bit_cast(unsigned, v); const auto r = __builtin_amdgcn_permlane32_swap(u, u, false, false); return __builtin_bit_cast(float, (unsigned)r[0]) + __builtin_bit_cast(float, (unsigned)r[1]); }
__device__ __forceinline__ float wave_sum(float v) {
    v += dpp_f<0xB1>(v); v += dpp_f<0x4E>(v); v += dpp_f<0x141>(v); v += dpp_f<0x140>(v);
    v = xsum16(v); return xsum32(v);
}
__device__ __forceinline__ unsigned cvt_pk_bf16(float lo, float hi) { unsigned r; asm volatile("v_cvt_pk_bf16_f32 %0, %1, %2" : "=v"(r) : "v"(lo), "v"(hi)); return r; }
#ifndef WT_STORES
#define WT_STORES 0
#endif
__device__ __forceinline__ void st16(void* p, u32x4 v) {
#if WT_STORES
    asm volatile("global_store_dwordx4 %0, %1, off sc1\n\ts_nop 1" :: "v"(p), "v"(v) : "memory");
#else
    *(u32x4*)p = v;
#endif
}
constexpr float YSC = 32.0f, YSCI = 1.0f / 32.0f, LOG2E = 1.4426950408889634f;
__device__ __forceinline__ f32x4 fp8x4(unsigned w) { const f32x2 lo = __builtin_amdgcn_cvt_pk_f32_fp8((int)w, false), hi = __builtin_amdgcn_cvt_pk_f32_fp8((int)w, true); return (f32x4){lo[0], lo[1], hi[0], hi[1]}; }
typedef int v8i __attribute__((ext_vector_type(8)));
typedef int v4i __attribute__((ext_vector_type(4)));
__device__ __forceinline__ unsigned pk4_fp8(float a, float b, float c, float d) {
    int w = 0; w = __builtin_amdgcn_cvt_pk_fp8_f32(a, b, w, false); w = __builtin_amdgcn_cvt_pk_fp8_f32(c, d, w, true); return (unsigned)w;
}
#define LDS_WAIT() asm volatile("s_waitcnt lgkmcnt(0)" ::: "memory")
#define VM_WAIT() asm volatile("s_waitcnt vmcnt(0)" ::: "memory")

#define XB_TMO      128
#define XB_XCNT(j)  (256  + 64 * (j))
#define XB_XSUB(j)  (1280 + 64 * (j))
#define XB_XGEN(j)  (2304 + 64 * (j))
#define XB_TOP      3328
#define XB_TOPGEN   3392
#define XCD_BAR_WORDS 3456
#define XB_SPIN_CAP (1u << 18)
__device__ __forceinline__ unsigned xb_ld(unsigned* p)              { return __hip_atomic_load(p, __ATOMIC_RELAXED, __HIP_MEMORY_SCOPE_AGENT); }
__device__ __forceinline__ unsigned xb_add(unsigned* p, unsigned v) { return __hip_atomic_fetch_add(p, v, __ATOMIC_RELAXED, __HIP_MEMORY_SCOPE_AGENT); }
__device__ __forceinline__ unsigned xb_xcc_id() { return (unsigned)__builtin_amdgcn_s_getreg((3 << 11) | 20) & 0xFu; }
#define XB_SPIN(cond, bar) do { unsigned _sp = 0; while (cond) { __builtin_amdgcn_s_sleep(1); \
    if ((++_sp & 255u) == 0u) { if (xb_ld(&(bar)[XB_TMO])) break; if (_sp > XB_SPIN_CAP) { atomicAdd(&(bar)[XB_TMO], 1u); break; } } } } while (0)
struct XcdBarrier { unsigned* bar; unsigned x; volatile LAS unsigned* st; };
__device__ __forceinline__ XcdBarrier xcd_barrier_post(unsigned* bar, volatile LAS unsigned* st) {
    XcdBarrier b; b.bar = bar; b.x = xb_xcc_id(); b.st = st;
    if (threadIdx.x == 0) (void)xb_add(&bar[XB_XCNT(b.x)], 1u);
    return b;
}
__device__ __forceinline__ void xcd_barrier_complete(unsigned* bar, unsigned x, unsigned& nloc, unsigned& nx) {
    const unsigned G = gridDim.x * gridDim.y * gridDim.z;
    unsigned sum, cnt, mine, sp = 0u;
    for (;;) {
        sum = 0u; cnt = 0u; mine = 0u;
#pragma unroll
        for (unsigned j = 0; j < 16; ++j) { const unsigned c = xb_ld(&bar[XB_XCNT(j)]); sum += c; cnt += (c > 0u) ? 1u : 0u; mine = (j == x) ? c : mine; }
        if (sum == G) break;
        __builtin_amdgcn_s_sleep(1);
        if ((++sp & 255u) == 0u) { if (xb_ld(&bar[XB_TMO])) break; if (sp > XB_SPIN_CAP) { atomicAdd(&bar[XB_TMO], 1u); break; } }
    }
    nloc = mine > 0u ? mine : 1u; nx = cnt > 0u ? cnt : 1u;
}
__device__ __forceinline__ void xcd_barrier(const XcdBarrier& b) {
    asm volatile("s_waitcnt vmcnt(0)" ::: "memory");
    __syncthreads();
    if (threadIdx.x == 0) {
        unsigned* bar = b.bar;
        __builtin_amdgcn_s_waitcnt(0);
        unsigned nloc = b.st[0], nx = b.st[1];
        if (nloc == 0u) { xcd_barrier_complete(bar, b.x, nloc, nx); b.st[0] = nloc; b.st[1] = nx; }
        const unsigned old = xb_add(&bar[XB_XSUB(b.x)], 1u);
        const unsigned gen = old / nloc;
        if (old + 1u == (gen + 1u) * nloc) {
            __builtin_amdgcn_fence(__ATOMIC_RELEASE, "agent");
            asm volatile("s_waitcnt vmcnt(0)" ::: "memory");
            const unsigned og = xb_add(&bar[XB_TOP], 1u);
            const unsigned tg = og / nx;
            if (og + 1u == (tg + 1u) * nx) xb_add(&bar[XB_TOPGEN], 1u);
            else XB_SPIN(xb_ld(&bar[XB_TOPGEN]) == tg, bar);
            __builtin_amdgcn_fence(__ATOMIC_ACQUIRE, "agent");
            asm volatile("s_waitcnt vmcnt(0)" ::: "memory");
        } else {
            XB_SPIN(xb_ld(&bar[XB_TOPGEN]) == gen, bar);
            __builtin_amdgcn_fence(__ATOMIC_ACQUIRE, "agent");
            asm volatile("s_waitcnt vmcnt(0)" ::: "memory");
        }
    }
    __syncthreads();
}

struct Params { const float* in[20]; float* out; unsigned char* ws; int ph_lo, ph_hi, use_bar, pad; };
enum { I_X = 0, I_C, I_NG, I_WMOD, I_BMOD, I_PW, I_PB, I_PS, I_GWIN, I_GWG, I_GBG, I_GNG, I_GWO, I_MWG, I_MBG, I_MWE, I_MBE, I_MWI, I_MWO, I_FNG };

namespace pg8 {
constexpr int BM = 256, BK = 64, HALF = 128, HTB = HALF * BK * 2, STAGE_BYTES = 8 * HTB, NXCD = 8, WGM = 8;
__host__ __device__ __forceinline__ int lds_byte(int r, int c) { const int st = (r >> 4) * 2 + (c >> 5), rr = r & 15, cc = c & 31, ob = rr * 64 + cc * 2; return st * 1024 + (ob ^ (((ob >> 9) & 1) << 5)); }
__host__ __device__ __forceinline__ void stage_rc(int b, int& R, int& C) { const int st = b / 1024, sb = b % 1024, swz = sb ^ (((sb >> 9) & 1) << 5); R = (st >> 1) * 16 + swz / 64; C = (st & 1) * 32 + (swz % 64) / 2; }
__host__ __device__ __forceinline__ int perm32(int rho) { const int n = rho >> 4, i = rho & 15; return 8 * (i >> 2) + 4 * n + (i & 3); }

struct Unit { int pm, pn, e, rows, slot0; };

template <class P>
__device__ __forceinline__ void gemm_phase(LAS unsigned char* lds, LAS unsigned char* idxb, const P& p) {
    int tid = threadIdx.x; asm volatile("" : "+v"(tid));
    const int wid = __builtin_amdgcn_readfirstlane(tid >> 6), lane = tid & 63, wr = wid >> 2, wc = wid & 3, fr = lane & 15, fq = lane >> 4;
    const int K = p.K, nt = K / BK, lda = p.lda;
    unsigned voffB[2];
#pragma unroll
    for (int i = 0; i < 2; ++i) { int R, C; stage_rc(tid * 16 + i * 8192, R, C);
        const int Rb = P::WIDE ? 64 * (R >> 5) + 16 * ((R & 15) >> 2) + 4 * ((R >> 4) & 1) + (R & 3) : P::LINE ? 64 * (R >> 5) + perm32(R & 31) : (R & ~31) + perm32(R & 31);
        voffB[i] = (unsigned)(Rb * K + C) * 2u; }
    unsigned vc[2][2];
    const size_t kstep = (size_t)(BK * 2);
    const size_t hstepB = (size_t)(P::WIDE ? 8 : P::LINE ? 32 : HALF) * K * 2;
    const unsigned ldsw = (unsigned)wid * 1024u;
    const int aoff = lds_byte(wr * 64 + fr, fq * 8), boff = lds_byte(wc * 32 + fr, fq * 8);
#define PG8_SA(b, h) (((b) * 2 + (h)) * HTB)
#define PG8_SB(b, h) ((4 + (b) * 2 + (h)) * HTB)
#define PG8_STAGE2(bufoff, gptr, v0, v1) do { \
        __builtin_amdgcn_global_load_lds((const unsigned*)((const char*)(gptr) + (v0)), (LAS unsigned*)(lds + (bufoff) + ldsw), 16, 0, 0); \
        __builtin_amdgcn_global_load_lds((const unsigned*)((const char*)(gptr) + (v1)), (LAS unsigned*)(lds + (bufoff) + ldsw + 8192), 16, 0, 0); } while (0)
#define PG8_STAGEB(bufoff, gptr) PG8_STAGE2(bufoff, gptr, voffB[0], voffB[1])
#define PG8_STAGEA(bufoff, gptr, V, h) PG8_STAGE2(bufoff, gptr, V[h][0], V[h][1])
#define PG8_LDA(dst, b, h) do { _Pragma("unroll") for (int m = 0; m < 4; ++m) _Pragma("unroll") for (int k = 0; k < 2; ++k) dst[m][k] = *(const LAS bf16x8*)(lds + PG8_SA(b, h) + aoff + m * 2048 + k * 1024); } while (0)
#define PG8_LDB(dst, b, h) do { _Pragma("unroll") for (int n = 0; n < 2; ++n) _Pragma("unroll") for (int k = 0; k < 2; ++k) dst[n][k] = *(const LAS bf16x8*)(lds + PG8_SB(b, h) + boff + n * 2048 + k * 1024); } while (0)
#define PG8_MMA(ai, bj, At, Bt) do { __builtin_amdgcn_s_setprio(1); _Pragma("unroll") for (int m = 0; m < 4; ++m) _Pragma("unroll") for (int n = 0; n < 2; ++n) _Pragma("unroll") for (int k = 0; k < 2; ++k) \
        acc[ai][bj][m][n] = __builtin_amdgcn_mfma_f32_16x16x32_bf16(Bt[n][k], At[m][k], acc[ai][bj][m][n], 0, 0, 0); __builtin_amdgcn_s_setprio(0); } while (0)
#define PG8_MMA8(ai, bj, At, Bt) do { __builtin_amdgcn_s_setprio(1); _Pragma("unroll") for (int m = 0; m < 4; ++m) _Pragma("unroll") for (int n = 0; n < 2; ++n) { \
        const v4i _b0 = __builtin_bit_cast(v4i, Bt[n][0]), _b1 = __builtin_bit_cast(v4i, Bt[n][1]), _a0 = __builtin_bit_cast(v4i, At[m][0]), _a1 = __builtin_bit_cast(v4i, At[m][1]); \
        acc[ai][bj][m][n] = __builtin_amdgcn_mfma_scale_f32_16x16x128_f8f6f4(__builtin_shufflevector(_b0, _b1, 0, 1, 2, 3, 4, 5, 6, 7), __builtin_shufflevector(_a0, _a1, 0, 1, 2, 3, 4, 5, 6, 7), \
                                                                                acc[ai][bj][m][n], 0, 0, 0, P::SCALE_B, 0, P::SCALE_A); } __builtin_amdgcn_s_setprio(0); } while (0)
#define PG8_MM(ai, bj, At, Bt) do { if constexpr (P::FP8) PG8_MMA8(ai, bj, At, Bt); else PG8_MMA(ai, bj, At, Bt); } while (0)
#define PG8_WAIT_V(n) asm volatile("s_waitcnt vmcnt(" #n ")" ::: "memory")
#define PG8_WAIT_L(n) asm volatile("s_waitcnt lgkmcnt(" #n ")" ::: "memory")
#define PG8_BAR __builtin_amdgcn_s_barrier()
#define PG8_SCHED __builtin_amdgcn_sched_barrier(0)
#define PG8_IDX_ISSUE(U, bufi) do { __builtin_amdgcn_global_load_lds((const unsigned*)(p.idx_src(U) + (size_t)(wid * 64 + lane) * 4), (LAS unsigned*)(idxb + (bufi) * 2048 + wid * 256), 4, 0, 0); } while (0)
#define PG8_AOFF(V, U, ibp) do { int _tt = tid; asm volatile("" : "+v"(_tt)); _Pragma("unroll") for (int i = 0; i < 2; ++i) { int _R, _C; stage_rc(_tt * 16 + i * 8192, _R, _C); _Pragma("unroll") for (int h = 0; h < 2; ++h) \
        V[h][i] = P::GATHER ? (p.a_rowoff(U, ibp, h * HALF + _R) + (unsigned)_C * 2u) : (unsigned)((h * HALF + _R) * lda + _C) * 2u; } } while (0)
    Unit cur, nxt; int ui = 0;
    if (!p.unit(0, cur)) return;
    int ib0 = 0, ib1 = 1, ib2 = 2;
    f32x4 acc[2][2][4][2];
#pragma unroll
    for (int a = 0; a < 2; ++a)
#pragma unroll
        for (int b = 0; b < 2; ++b)
#pragma unroll
            for (int m = 0; m < 4; ++m)
#pragma unroll
                for (int n = 0; n < 2; ++n) acc[a][b][m][n] = (f32x4){0.f, 0.f, 0.f, 0.f};
    bf16x8 At[4][2], B0[2][2], B1[2][2];
    const char* cA = p.a_base(cur); const char* cB = p.b_base(cur);
    if constexpr (P::GATHER) PG8_IDX_ISSUE(cur, 0);
    PG8_STAGEB(PG8_SB(0, 0), cB); PG8_STAGEB(PG8_SB(0, 1), cB + hstepB);
    if constexpr (P::GATHER && P::IDXA) { PG8_WAIT_V(4); PG8_BAR; }
    PG8_AOFF(vc, cur, (const LAS unsigned*)(idxb + ib0 * 2048));
    PG8_STAGEA(PG8_SA(0, 0), cA, vc, 0); PG8_STAGEA(PG8_SA(0, 1), cA, vc, 1);
    if (wr == 1) PG8_BAR;
    PG8_WAIT_V(2); PG8_BAR;
    PG8_STAGEB(PG8_SB(1, 0), cB + kstep); PG8_STAGEA(PG8_SA(1, 0), cA + kstep, vc, 0); PG8_STAGEB(PG8_SB(1, 1), cB + hstepB + kstep);
    PG8_WAIT_V(6); PG8_BAR;
    for (;;) {
        const bool has_next = p.unit(ui + 1, nxt);
        const char* nA = has_next ? p.a_base(nxt) : cA; const char* nB = has_next ? p.b_base(nxt) : cB;
        const bool full0 = !(P::GATHER || P::FP8) || cur.rows > 64 * wr, full = !(P::GATHER || P::FP8) || cur.rows > HALF + 64 * wr;
        if constexpr (P::GATHER) { if (has_next) PG8_IDX_ISSUE(nxt, ib1); }
        for (int t = 0; t < nt; t += 2) {
            const bool last = (t == nt - 2);
            const char* a1 = cA + (size_t)(t + 1) * kstep;
            const char* a2 = last ? nA : cA + (size_t)(t + 2) * kstep; const char* b2 = last ? nB : cB + (size_t)(t + 2) * kstep;
            const char* a3 = a2 + kstep; const char* b3 = b2 + kstep;
            if constexpr (P::HEADSCALE) { constexpr int TH = P::FP8 ? 2 : 4;
                if (t > 0 && t < 4 * TH && (t % TH) == 0) p.rescale(acc, ui, t / TH - 1, wr, fr); }
            PG8_LDB(B0, 0, 0); PG8_LDB(B1, 0, 1); PG8_SCHED; PG8_LDA(At, 0, 0);
            if (P::PADK && last) PG8_STAGE2(PG8_SA(1, 1), cA, 0u, 0u); else PG8_STAGEA(PG8_SA(1, 1), a1, vc, 1);
            PG8_WAIT_V(8); PG8_WAIT_L(0); PG8_BAR; if (full0) { PG8_MM(0, 0, At, B0); PG8_MM(0, 1, At, B1); } PG8_BAR; PG8_SCHED;
            if constexpr (P::GATHER) { if (last && has_next) { PG8_AOFF(vc, nxt, (const LAS unsigned*)(idxb + ib1 * 2048)); } }
            PG8_LDA(At, 0, 1); PG8_STAGEB(PG8_SB(0, 0), b2); PG8_STAGEB(PG8_SB(0, 1), b2 + hstepB); PG8_STAGEA(PG8_SA(0, 0), a2, vc, 0);
            PG8_WAIT_V(8); PG8_WAIT_L(0); PG8_BAR; if (full) { PG8_MM(1, 0, At, B0); PG8_MM(1, 1, At, B1); } PG8_BAR; PG8_SCHED;
            PG8_LDB(B0, 1, 0); PG8_LDB(B1, 1, 1); PG8_SCHED; PG8_LDA(At, 1, 0); PG8_STAGEA(PG8_SA(0, 1), a2, vc, 1);
            PG8_WAIT_V(8); PG8_WAIT_L(0); PG8_BAR; if (full0 && !(P::PADK && last)) { PG8_MM(0, 0, At, B0); PG8_MM(0, 1, At, B1); } PG8_BAR; PG8_SCHED;
            PG8_LDA(At, 1, 1);
            if (P::PADK && t == nt - 4) { PG8_STAGE2(PG8_SB(1, 0), cB, 0u, 0u); PG8_STAGE2(PG8_SB(1, 1), cB, 0u, 0u); PG8_STAGE2(PG8_SA(1, 0), cA, 0u, 0u); }
            else { PG8_STAGEB(PG8_SB(1, 0), b3); PG8_STAGEB(PG8_SB(1, 1), b3 + hstepB); PG8_STAGEA(PG8_SA(1, 0), a3, vc, 0); }
            PG8_WAIT_V(8); PG8_WAIT_L(0); PG8_BAR; if (full && !(P::PADK && last)) { PG8_MM(1, 0, At, B0); PG8_MM(1, 1, At, B1); } PG8_BAR; PG8_SCHED;
        }
        if (wr == 0) PG8_BAR;
        if constexpr (P::HEADSCALE) p.rescale(acc, ui, 3, wr, fr);
        p.epi(acc, cur, (const LAS unsigned*)(idxb + ib0 * 2048), wr, wc, fr, fq);
        if (!has_next) break;
#pragma unroll
        for (int a = 0; a < 2; ++a)
#pragma unroll
            for (int b = 0; b < 2; ++b)
#pragma unroll
                for (int m = 0; m < 4; ++m)
#pragma unroll
                    for (int n = 0; n < 2; ++n) acc[a][b][m][n] = (f32x4){0.f, 0.f, 0.f, 0.f};
        cur = nxt; cA = nA; cB = nB; ++ui;
        { const int t0 = ib0; ib0 = ib1; ib1 = ib2; ib2 = t0; }
        if (wr == 1) PG8_BAR;
    }
    PG8_WAIT_V(0);
    PG8_BAR;
#undef PG8_SA
#undef PG8_SB
#undef PG8_STAGE2
#undef PG8_STAGEB
#undef PG8_STAGEA
#undef PG8_LDA
#undef PG8_LDB
#undef PG8_MMA
#undef PG8_MMA8
#undef PG8_MM
#undef PG8_WAIT_V
#undef PG8_WAIT_L
#undef PG8_BAR
#undef PG8_SCHED
#undef PG8_IDX_ISSUE
#undef PG8_AOFF
}

struct PlainGemm {
    static constexpr bool GATHER = false, HEADSCALE = false, FP8 = false, PADK = false, WIDE = false, LINE = true, IDXA = false; static constexpr int SCALE_A = 0, SCALE_B = 0, CW = LINE ? 64 : 32, CB = LINE ? 32 : HALF;
    const bf16_t* A; const bf16_t* Bt; bf16_t* O; int N, K, lda, ldc, acol; int G, c;
    __device__ __forceinline__ bool unit(int i, Unit& u) const {
        const int nM = T / BM, nN = N / BM, nwg = nM * nN;
        const long L = (long)i * G + c; if (L >= nwg) return false;
        int wgid = (int)L; { const int q = nwg / NXCD, r = nwg % NXCD, xcd = wgid % NXCD, off = wgid / NXCD; wgid = (xcd < r ? xcd * (q + 1) : r * (q + 1) + (xcd - r) * q) + off; }
        const int nig = WGM * nN, gid = wgid / nig, fm = gid * WGM, gsz = (nM - fm) < WGM ? (nM - fm) : WGM;
        u.pm = fm + ((wgid % nig) % gsz); u.pn = (wgid % nig) / gsz; u.e = 0; { int rr = 256; asm volatile("" : "+s"(rr)); u.rows = rr; } u.slot0 = 0; return true;
    }
    __device__ __forceinline__ const char* a_base(const Unit& u) const { return (const char*)(A + (size_t)u.pm * BM * lda + (size_t)u.pn * acol); }
    __device__ __forceinline__ const char* b_base(const Unit& u) const { return (const char*)(Bt + (size_t)u.pn * BM * K); }
    __device__ __forceinline__ const char* idx_src(const Unit&) const { return nullptr; }
    __device__ __forceinline__ unsigned a_rowoff(const Unit&, const LAS unsigned*, int) const { return 0u; }
    __device__ __forceinline__ void epi(const f32x4 (&acc)[2][2][4][2], const Unit& u, const LAS unsigned*, int wr, int wc, int fr, int fq) const {
        const int row0 = u.pm * BM + wr * 64 + fr, col0 = u.pn * BM + wc * CW + 8 * fq;
#pragma unroll
        for (int ai = 0; ai < 2; ++ai)
#pragma unroll
            for (int m = 0; m < 4; ++m) { bf16_t* rowp = O + (size_t)(row0 + ai * HALF + m * 16) * ldc + col0;
#pragma unroll
                for (int bj = 0; bj < 2; ++bj) { const f32x4 v0 = acc[ai][bj][m][0], v1 = acc[ai][bj][m][1];
                    u32x4 w; w.x = cvt_pk_bf16(v0[0], v0[1]); w.y = cvt_pk_bf16(v0[2], v0[3]); w.z = cvt_pk_bf16(v1[0], v1[1]); w.w = cvt_pk_bf16(v1[2], v1[3]);
                    st16(rowp + bj * CB, w); } }
    }
};
template <int SB>
struct PlainGemmF8 : PlainGemm { static constexpr bool FP8 = true; static constexpr int SCALE_A = 0x7F7F7F7F, SCALE_B = SB; };
struct HeadScaleGemm : PlainGemm {
    static constexpr bool HEADSCALE = true;
    const LAS float* tab;
    __device__ __forceinline__ void rescale(f32x4 (&acc)[2][2][4][2], int ui, int h, int wr, int fr) const {
#pragma unroll
        for (int ai = 0; ai < 2; ++ai)
#pragma unroll
            for (int m = 0; m < 4; ++m) { const float f = tab[(ui * 4 + h) * 256 + (wr * 64 + fr) + (ai * HALF + m * 16)];
#pragma unroll
                for (int bj = 0; bj < 2; ++bj)
#pragma unroll
                    for (int n = 0; n < 2; ++n) acc[ai][bj][m][n] = acc[ai][bj][m][n] * f; }
    }
};
struct HeadScaleGemmF8 : HeadScaleGemm { static constexpr bool FP8 = true; static constexpr int SCALE_A = 0x7F7F7F7F, SCALE_B = 0x7A7A7A7A; };
template <class Base, bool POOL>
struct ResidEpi : Base {
    const bf16_t* Xin; bf16_t* Xout; const float* g1; const float* ps; const float* pb;
    __device__ __forceinline__ void epi(const f32x4 (&acc)[2][2][4][2], const Unit& u, const LAS unsigned*, int wr, int wc, int fr, int fq) const {
        constexpr int CW = Base::CW, CB = Base::CB;
        const int row0 = u.pm * BM + wr * 64 + fr, col0 = u.pn * BM + wc * CW + 8 * fq;
        const float* gp = g1 + (size_t)(u.pm >> 4) * 6144 + col0;
        f32x4 cC[2][2], cD[2][2];
#pragma unroll
        for (int bj = 0; bj < 2; ++bj)
#pragma unroll
            for (int n = 0; n < 2; ++n) {
                cC[bj][n] = *(const f32x4*)(gp + bj * CB + 4 * n);
                if (POOL) { const f32x4 s4 = *(const f32x4*)(ps + col0 + bj * CB + 4 * n), b4 = *(const f32x4*)(pb + col0 + bj * CB + 4 * n); cC[bj][n] = cC[bj][n] * s4; cD[bj][n] = cC[bj][n] * b4; }
            }
#pragma unroll
        for (int ai = 0; ai < 2; ++ai)
#pragma unroll
            for (int m = 0; m < 4; ++m) { const size_t ro = (size_t)(row0 + ai * HALF + m * 16) * this->ldc + col0;
#pragma unroll
                for (int bj = 0; bj < 2; ++bj) {
                    const u32x4 xi = *(const u32x4*)(Xin + ro + bj * CB);
                    const f32x4 x0 = (f32x4){bflo(xi.x), bfhi(xi.x), bflo(xi.y), bfhi(xi.y)}, x1 = (f32x4){bflo(xi.z), bfhi(xi.z), bflo(xi.w), bfhi(xi.w)};
                    f32x4 v0 = x0 + acc[ai][bj][m][0] * cC[bj][0], v1 = x1 + acc[ai][bj][m][1] * cC[bj][1];
                    if (POOL) { v0 = v0 + cD[bj][0]; v1 = v1 + cD[bj][1]; }
                    u32x4 w; w.x = cvt_pk_bf16(v0[0], v0[1]); w.y = cvt_pk_bf16(v0[2], v0[3]); w.z = cvt_pk_bf16(v1[0], v1[1]); w.w = cvt_pk_bf16(v1[2], v1[3]);
                    st16(Xout + ro + bj * CB, w); }
                asm volatile("" ::: "memory"); }
    }
};
struct MoeBase {
    static constexpr bool GATHER = true, HEADSCALE = false, FP8 = false, PADK = false, WIDE = false, LINE = false, IDXA = true; static constexpr int SCALE_A = 0, SCALE_B = 0;
    const LAS int* ut; const unsigned char* list;
    __device__ __forceinline__ bool unit(int i, Unit& u) const {
        if (i >= 8) return false;
        const LAS int* q = ut + i * 8; if (q[0] < 0) return false;
        u.e = q[0]; u.pm = q[1]; u.pn = q[2]; u.rows = q[3]; u.slot0 = q[4]; return true;
    }
    __device__ __forceinline__ const char* idx_src(const Unit& u) const { return (const char*)(list + ((size_t)u.e * LISTCAP + (size_t)u.pm * 256) * 8); }
};
struct Moe1 : MoeBase {
#if M1_FP8
    static constexpr bool FP8 = true; static constexpr int SCALE_A = 0x7F7F7F7F  , SCALE_B = 0x7A7A7A7A  ;
#endif
    const bf16_t* H; const bf16_t* W; bf16_t* ACT; int K, lda;
    __device__ __forceinline__ const char* a_base(const Unit&) const { return (const char*)H; }
    __device__ __forceinline__ const char* b_base(const Unit& u) const { return (const char*)W + ((size_t)u.e * 768 + (size_t)u.pn * 256) * (M1_FP8 ? 1024 : 2048); }
    __device__ __forceinline__ unsigned a_rowoff(const Unit& u, const LAS unsigned* ib, int r) const { const int rr = r < u.rows ? r : u.rows - 1; const unsigned id = ib[2 * rr]; return (id >> 1) * (M1_FP8 ? 1024u : 2048u); }
    __device__ __forceinline__ void epi(const f32x4 (&acc)[2][2][4][2], const Unit& u, const LAS unsigned*, int wr, int wc, int fr, int fq) const {
        const int row0 = u.slot0 + wr * 64 + fr, col0 = u.pn * 128 + wc * 32 + 8 * fq;
#pragma unroll
        for (int ai = 0; ai < 2; ++ai)
#pragma unroll
            for (int m = 0; m < 4; ++m) { bf16_t* rowp = ACT + (size_t)(row0 + ai * HALF + m * 16) * FF + col0;
                float v[8];
#pragma unroll
                for (int n = 0; n < 2; ++n)
#pragma unroll
                    for (int j = 0; j < 4; ++j) { const float g = acc[ai][0][m][n][j], up = acc[ai][1][m][n][j]; v[n * 4 + j] = M2_FP8 ? g * __builtin_amdgcn_rcpf(1.0f + __builtin_amdgcn_exp2f(-g)) * up : g * __builtin_amdgcn_rcpf(1.0f + __expf(-g)) * up; }
#if M2_FP8
                unsigned char* r8 = (unsigned char*)ACT + (size_t)(row0 + ai * HALF + m * 16) * 512 + col0;
                u32x2 w8; w8.x = pk4_fp8(v[0], v[1], v[2], v[3]); w8.y = pk4_fp8(v[4], v[5], v[6], v[7]);
                *(u32x2*)r8 = w8;
                (void)rowp;
#else
                u32x4 w; w.x = cvt_pk_bf16(v[0], v[1]); w.y = cvt_pk_bf16(v[2], v[3]); w.z = cvt_pk_bf16(v[4], v[5]); w.w = cvt_pk_bf16(v[6], v[7]);
                st16(rowp, w);
#endif
            }
    }
};
struct Moe2 : MoeBase {
#if M2_FP8
    static constexpr bool FP8 = true, PADK = true  , WIDE = Y_FP8 != 0, IDXA = false  ; static constexpr int SCALE_A = 0x7F7F7F7F, SCALE_B = 0x78787878  ;
#endif
    const bf16_t* ACT; const bf16_t* W; bf16_t* Y; int K, lda;
    __device__ __forceinline__ const char* a_base(const Unit&) const { return (const char*)ACT; }
    __device__ __forceinline__ const char* b_base(const Unit& u) const { return (const char*)W + ((size_t)u.e * 1024 + (size_t)u.pn * 256) * (M2_FP8 ? 512 : FF * 2); }
    __device__ __forceinline__ unsigned a_rowoff(const Unit& u, const LAS unsigned*, int r) const { return (unsigned)(u.slot0 + r) * (unsigned)(M2_FP8 ? 512 : FF * 2); }
    __device__ __forceinline__ void epi(const f32x4 (&acc)[2][2][4][2], const Unit& u, const LAS unsigned* ib, int wr, int wc, int fr, int fq) const {
        const int col0 = WIDE ? u.pn * 256 + wc * 64 + 16 * fq : u.pn * 256 + wc * 32 + 8 * fq;
#pragma unroll
        for (int ai = 0; ai < 2; ++ai)
#pragma unroll
            for (int m = 0; m < 4; ++m) { int r = ai * HALF + wr * 64 + m * 16 + fr; asm volatile("" : "+v"(r));
                if (r < u.rows) { const unsigned id = ib[2 * r]; const float wt = __builtin_bit_cast(float, ib[2 * r + 1]);
#if Y_FP8
                    unsigned char* rowp = (unsigned char*)Y + ((size_t)(id & 1u) * T + (size_t)(id >> 1)) * D + col0; const float ws_ = wt * YSC;
                    const f32x4 v0 = acc[ai][0][m][0] * ws_, v1 = acc[ai][0][m][1] * ws_, v2 = acc[ai][1][m][0] * ws_, v3 = acc[ai][1][m][1] * ws_;
                    u32x4 w; w.x = pk4_fp8(v0[0], v0[1], v0[2], v0[3]); w.y = pk4_fp8(v1[0], v1[1], v1[2], v1[3]); w.z = pk4_fp8(v2[0], v2[1], v2[2], v2[3]); w.w = pk4_fp8(v3[0], v3[1], v3[2], v3[3]);
                    *(u32x4*)rowp = w; }
#else
                    bf16_t* rowp = Y + ((size_t)(id & 1u) * T + (size_t)(id >> 1)) * D + col0;
#pragma unroll
                    for (int bj = 0; bj < 2; ++bj) { const f32x4 v0 = acc[ai][bj][m][0] * wt, v1 = acc[ai][bj][m][1] * wt;
                        u32x4 w; w.x = cvt_pk_bf16(v0[0], v0[1]); w.y = cvt_pk_bf16(v0[2], v0[3]); w.z = cvt_pk_bf16(v1[0], v1[1]); w.w = cvt_pk_bf16(v1[2], v1[3]);
                        st16(rowp + bj * HALF, w); } }
#endif
                asm volatile("" ::: "memory"); }
    }
};
}

constexpr int L_UT2 = L_TT + 16;
__device__ __forceinline__ void moe_build_units(LAS unsigned char* lds, unsigned* cntw, int G, int c) {
    int tid = threadIdx.x; asm volatile("" : "+v"(tid));
    const int lane = tid & 63;
    __syncthreads();
    if (tid < 64) {
        const int cnt = (int)__hip_atomic_load(cntw + lane * 16, __ATOMIC_RELAXED, __HIP_MEMORY_SCOPE_AGENT);
        const int tiles = (cnt + 255) >> 8;
        int incl = tiles;
#pragma unroll
        for (int o = 1; o < 64; o <<= 1) { const int v = __shfl_up(incl, o); if (lane >= o) incl += v; }
        const int etb = incl - tiles, TT = __shfl(incl, 63);
#pragma unroll
        for (int tb = 0; tb < 2; ++tb) {
            const int NT = 3 + tb, U = TT * NT; LAS int* ut = (LAS int*)(lds + (tb ? L_UT2 : L_UT));
#pragma unroll
            for (int u = 0; u < 8; ++u) {
                const int L = u * G + c;
                int wgid = L; { const int q = U / 8, r = U % 8, xcd = wgid % 8, off = wgid / 8; wgid = (xcd < r ? xcd * (q + 1) : r * (q + 1) + (xcd - r) * q) + off; }
                const int tau = wgid / NT, pn = wgid % NT;
                const bool hit = L < U && tau >= etb && tau < etb + tiles;
                if (__ballot(hit) == 0ull) { if (lane == 0) ut[u * 8] = -1; }
                else if (hit) { const int mt = tau - etb, rem = cnt - mt * 256; ut[u * 8 + 0] = lane; ut[u * 8 + 1] = mt; ut[u * 8 + 2] = pn; ut[u * 8 + 3] = rem > 256 ? 256 : rem; ut[u * 8 + 4] = tau * 256; }
            }
        }
    }
    __syncthreads();
}

constexpr int TK_AH = 0, TK_ROWB = 2064, TK_AL = 33024, TK_RED = 66048, TK_LOGIT = 107008, TK_COEF = 112128, TK_AE = 132608, TK_AW = 133632, TK_AR = 134656, TK_HIST = 135680, TK_BASE = 135936;
static_assert(TK_BASE + 256 <= L_MISC, "token-phase LDS map");
struct RowRaw { f32x4 x[4]; u32x2 xb[4]; u32x2 a[4]; u32x2 b[4]; };
__device__ __forceinline__ f32x4 bf4(u32x2 w) { return (f32x4){bflo(w.x), bfhi(w.x), bflo(w.y), bfhi(w.y)}; }

template <int MODE, bool FROM_IN>
__device__ __forceinline__ void tk_issue(RowRaw& R, const Params& p, int layer, int t, int lane) {
    unsigned char* ws = p.ws;
    constexpr bool from_in = FROM_IN;
    if (from_in || !XB_BF16) {
        const f32x4* xr = (const f32x4*)((from_in ? p.in[I_X] : (const float*)(ws + ((MODE == 2 && !FUSE_RES) ? WS_X2 : WS_X))) + (size_t)t * D) + lane;
#pragma unroll
        for (int j = 0; j < 4; ++j) R.x[j] = xr[64 * j];
    } else {
        const u32x2* xr = (const u32x2*)((const bf16_t*)(ws + ((MODE == 2 && !FUSE_RES) ? WS_X2 : WS_X)) + (size_t)t * D) + lane;
#pragma unroll
        for (int j = 0; j < 4; ++j) R.xb[j] = __builtin_nontemporal_load(xr + 64 * j);
    }
    if (MODE == 2 && FUSE_RES) {
    } else if (MODE == 2) {
        const u32x2* ur = (const u32x2*)((const bf16_t*)(ws + WS_U) + (size_t)t * D) + lane;
#pragma unroll
        for (int j = 0; j < 4; ++j) R.a[j] = __builtin_nontemporal_load(ur + 64 * j);
    } else if (!from_in) {
#if Y_FP8
        const unsigned* y0 = (const unsigned*)(ws + WS_Y + (size_t)t * D) + lane; const unsigned* y1 = (const unsigned*)(ws + WS_Y + (size_t)(T + t) * D) + lane;
#pragma unroll
        for (int j = 0; j < 4; ++j) { R.a[j].x = __builtin_nontemporal_load(y0 + 64 * j); R.b[j].x = __builtin_nontemporal_load(y1 + 64 * j); }
#else
        const u32x2* y0 = (const u32x2*)((const bf16_t*)(ws + WS_Y) + (size_t)t * D) + lane; const u32x2* y1 = (const u32x2*)((const bf16_t*)(ws + WS_Y) + (size_t)(T + t) * D) + lane;
#pragma unroll
        for (int j = 0; j < 4; ++j) { R.a[j] = __builtin_nontemporal_load(y0 + 64 * j); R.b[j] = __builtin_nontemporal_load(y1 + 64 * j); }
#endif
    }
}
template <int MODE, bool FROM_IN>
__device__ __forceinline__ void tk_row(const RowRaw& R, const Params& p, unsigned char* ws, LAS unsigned char* lds, int layer, int t, int rr, int lane, bool store) {
    constexpr bool from_in = FROM_IN;
    const LAS f32x4* cA4 = (const LAS f32x4*)(lds + TK_COEF); const LAS f32x4* cB4 = cA4 + 256; const LAS f32x4* cC4 = cA4 + 512; const LAS f32x4* cD4 = cA4 + 768; const LAS f32x4* cE4 = cA4 + 1024;
    f32x4 x[4];
#pragma unroll
    for (int j = 0; j < 4; ++j) {
        f32x4 xin = (XB_BF16 && MODE == 3) ? (f32x4){0.f, 0.f, 0.f, 0.f} : R.x[j];
        if (XB_BF16 && !from_in) xin = bf4(R.xb[j]);
        if (MODE == 2 && FUSE_RES) x[j] = xin;
        else if (MODE == 2) x[j] = xin + bf4(R.a[j]) * cC4[64 * j + lane] + cD4[64 * j + lane];
        else if (from_in) x[j] = xin;
        else if (Y_FP8) x[j] = xin + (fp8x4(R.a[j].x) + fp8x4(R.b[j].x)) * (cE4[64 * j + lane] * YSCI);
        else x[j] = xin + (bf4(R.a[j]) + bf4(R.b[j])) * cE4[64 * j + lane];
    }
    if (store && MODE != 3 && !(MODE == 2 && FUSE_RES)) {
        if (XB_BF16) {
            u32x2* xw = (u32x2*)((bf16_t*)(ws + (MODE == 2 ? WS_X : WS_X2)) + (size_t)t * D) + lane;
#pragma unroll
            for (int j = 0; j < 4; ++j) { u32x2 o; o.x = pk2(x[j][0], x[j][1]); o.y = pk2(x[j][2], x[j][3]); xw[64 * j] = o; }
        } else {
            f32x4* xw = (f32x4*)((float*)(ws + (MODE == 2 ? WS_X : WS_X2)) + (size_t)t * D) + lane;
#pragma unroll
            for (int j = 0; j < 4; ++j) xw[64 * j] = x[j];
        }
    }
    float ss = 0.f;
#pragma unroll
    for (int j = 0; j < 4; ++j) ss += (x[j][0] * x[j][0] + x[j][1] * x[j][1]) + (x[j][2] * x[j][2] + x[j][3] * x[j][3]);
    ss = wave_sum(ss);
    const float rstd = __builtin_amdgcn_rsqf(ss * (1.0f / D) + EPS);
#pragma unroll
    for (int j = 0; j < 4; ++j) {
        const f32x4 h = x[j] * rstd * cA4[64 * j + lane] + cB4[64 * j + lane];
        if (MODE == 3) { ((f32x4*)((ws == p.ws ? p.out : (float*)(ws + WS_X)) + (size_t)t * D))[64 * j + lane] = h; }
        else {
            u32x2 hi; hi.x = pk2(h[0], h[1]); hi.y = pk2(h[2], h[3]);
            if (MODE == 0) { *(LAS u32x2*)(lds + TK_AH + rr * TK_ROWB + (256 * j + 4 * lane) * 2) = hi; }
            else {
                if (MODE == 1 && G2_FP8) ((unsigned*)(ws + WS_H + (size_t)t * D))[64 * j + lane] = pk4_fp8(h[0], h[1], h[2], h[3]);
                else if (MODE == 2 && M1_FP8) ((unsigned*)(ws + WS_U + (size_t)t * D))[64 * j + lane] = pk4_fp8(h[0], h[1], h[2], h[3]);
                else ((u32x2*)((bf16_t*)(ws + WS_H) + (size_t)t * D))[64 * j + lane] = hi;
                if (MODE == 1 && G2_VR8) ((unsigned*)(ws + WS_U + 32 * MiB + (size_t)t * D))[64 * j + lane] = pk4_fp8(h[0], h[1], h[2], h[3]);
                const f32x4 r = h - bf4(hi);
                u32x2 lo; lo.x = pk2(r[0], r[1]); lo.y = pk2(r[2], r[3]);
                *(LAS u32x2*)(lds + TK_AH + rr * TK_ROWB + (256 * j + 4 * lane) * 2) = hi;
                *(LAS u32x2*)(lds + TK_AL + rr * TK_ROWB + (256 * j + 4 * lane) * 2) = lo;
            }
        }
    }
}
__device__ __forceinline__ void tk_pool_row(unsigned char* ws, LAS unsigned char* lds, int t, int ri, int lane) {
    const int pos = t & (SEQ - 1);
#pragma unroll
    for (int j = 0; j < 4; ++j) {
        const int win = 2 << j; const int cnt = (pos + 1) < win ? (pos + 1) : win;
        const LAS unsigned char* col = lds + TK_AH + (256 * j + 4 * lane) * 2;
        const f32x4 own = bf4(*(const LAS u32x2*)(col + ri * TK_ROWB));
        f32x4 s = own;
        for (int k = 1; k < cnt; ++k) s += bf4(*(const LAS u32x2*)(col + ((ri - k) & 31) * TK_ROWB));
        const f32x4 d = s * (1.0f / (float)cnt) - own;
        u32x2 o; o.x = pk2(d[0], d[1]); o.y = pk2(d[2], d[3]);
        ((u32x2*)((bf16_t*)(ws + WS_H) + (size_t)t * D))[64 * j + lane] = o;
    }
}
template <int MODE, bool FROM_IN>
__device__ __forceinline__ void tk_tile(const RowRaw (&R)[2], const Params& p, unsigned char* ws, LAS unsigned char* lds, int layer, int tok0, int tile, int tid, int lane, int w, const bf16x8 (&WRh)[4][(MODE == 2) ? 5 : 1], const bf16x8 (&WRl)[4][(MODE == 2) ? 5 : 1]) {
    constexpr bool HAS_MMA = (MODE == 1 || MODE == 2);
    constexpr int NCT = (MODE == 2) ? 5 : 1;
#pragma unroll
    for (int q = 0; q < 2; ++q) {
        const int rr = 2 * w + q;
        tk_row<MODE, FROM_IN>(R[q], p, ws, lds, layer, tok0 + tile * 16 + rr, MODE == 0 ? (16 * ((tile + 1) & 1) + rr) : rr, lane, true);
    }
    if (MODE == 0) {
        __syncthreads();
#pragma unroll 1
        for (int q = 0; q < 2; ++q) { const int rr = 2 * w + q; tk_pool_row(ws, lds, tok0 + tile * 16 + rr, 16 * ((tile + 1) & 1) + rr, lane); }
        __syncthreads();
    }
    if (HAS_MMA) {
        __syncthreads();
        f32x4 acc[NCT];
#pragma unroll
        for (int ct = 0; ct < NCT; ++ct) acc[ct] = (f32x4){0.f, 0.f, 0.f, 0.f};
#pragma unroll
        for (int ks = 0; ks < 4; ++ks) {
            const int kk = 128 * w + 32 * ks + 8 * (lane >> 4);
            const bf16x8 ah = *(const LAS bf16x8*)(lds + TK_AH + (lane & 15) * TK_ROWB + kk * 2);
            constexpr bool SPLIT = (MODE == 1) || ROUTER_SPLIT;
            bf16x8 al = ah;
            if (SPLIT) al = *(const LAS bf16x8*)(lds + TK_AL + (lane & 15) * TK_ROWB + kk * 2);
#pragma unroll
            for (int ct = 0; ct < NCT; ++ct) {
                acc[ct] = __builtin_amdgcn_mfma_f32_16x16x32_bf16(ah, WRh[ks][ct], acc[ct], 0, 0, 0);
                if (SPLIT) { acc[ct] = __builtin_amdgcn_mfma_f32_16x16x32_bf16(al, WRh[ks][ct], acc[ct], 0, 0, 0);
                             acc[ct] = __builtin_amdgcn_mfma_f32_16x16x32_bf16(ah, WRl[ks][ct], acc[ct], 0, 0, 0); }
            }
        }
        LAS float* red = (LAS float*)(lds + TK_RED);
#pragma unroll
        for (int ct = 0; ct < NCT; ++ct)
#pragma unroll
            for (int r = 0; r < 4; ++r) red[(w * 16 + 4 * (lane >> 4) + r) * NRT + 16 * ct + (lane & 15)] = acc[ct][r];
        __syncthreads();
        constexpr int NCOL = 16 * NCT;
        for (int idx = tid; idx < 16 * NCOL; idx += NTHR) {
            const int tk = idx / NCOL, n = idx % NCOL;
            float s = 0.f;
#pragma unroll
            for (int ww = 0; ww < 8; ++ww) s += red[(ww * 16 + tk) * NRT + n];
            if (MODE == 1) ((float*)(ws + WS_Z))[(size_t)(tok0 + tile * 16 + tk) * 16 + n] = s;
            else { const float* PAR = (const float*)(ws + WS_PAR); const float bias = n < 8 ? PAR[PAR_MBG + layer * 8 + n] : (n < 72 ? PAR[PAR_MBE + layer * 64 + n - 8] : 0.f); ((LAS float*)(lds + TK_LOGIT))[tk * NRT + n] = s + bias; }
        }
        if (MODE == 2) {
            __syncthreads();
            if (tid < 16) {
                const LAS float* lg = (const LAS float*)(lds + TK_LOGIT) + tid * NRT;
                int g = 0; float m = lg[0];
#pragma unroll
                for (int k = 1; k < 8; ++k) { const float v = lg[k]; if (v > m) { m = v; g = k; } }
                float sum = 0.f;
#pragma unroll
                for (int k = 0; k < 8; ++k) sum += __expf(lg[k] - m);
                const float pg = __builtin_amdgcn_rcpf(sum);
                const LAS float* le = lg + 8 + 8 * g;
                int e1 = 0; float l1 = le[0];
#pragma unroll
                for (int k = 1; k < 8; ++k) { const float v = le[k]; if (v > l1) { l1 = v; e1 = k; } }
                int e2 = -1; float l2 = -3.0e38f;
#pragma unroll
                for (int k = 0; k < 8; ++k) { const float v = le[k]; if (k != e1 && v > l2) { l2 = v; e2 = k; } }
                const float r = __expf(l2 - l1), inv = __builtin_amdgcn_rcpf(1.0f + r);
                const int a0 = (tile * 16 + tid) * 2;
                LAS int* ae = (LAS int*)(lds + TK_AE); LAS float* aw = (LAS float*)(lds + TK_AW); LAS int* ar = (LAS int*)(lds + TK_AR); LAS int* hist = (LAS int*)(lds + TK_HIST);
                const int f1 = g * 8 + e1, f2 = g * 8 + e2;
                ae[a0] = f1; aw[a0] = pg * inv; ar[a0] = atomicAdd((int*)&hist[f1], 1);
                ae[a0 + 1] = f2; aw[a0 + 1] = pg * r * inv; ar[a0 + 1] = atomicAdd((int*)&hist[f2], 1);
            }
        }
    }
}
template <int MODE, bool FROM_IN>
__device__ __forceinline__ void token_phase(const Params& p, LAS unsigned char* lds, int layer, bool dry = false) {
    int tid = threadIdx.x; asm volatile("" : "+v"(tid));
    const int lane = tid & 63, w = __builtin_amdgcn_readfirstlane(tid >> 6);
    const int c = blockIdx.x, tok0 = c * 128, b = tok0 / SEQ;
    unsigned char* ws = p.ws; unsigned char* wso = p.ws + (dry ? WS_DRY : 0);
    const float* MOD = (const float*)(ws + WS_MOD);
    LAS float* coef = (LAS float*)(lds + TK_COEF);
    const bool pool = (layer & 1) == 0; const int j2 = layer >> 1;
    RowRaw RA[2], RB[2];
#pragma unroll
    for (int q = 0; q < 2; ++q) tk_issue<MODE, FROM_IN>(RA[q], p, layer, tok0 + 2 * w + q, lane);
    for (int k = tid; k < D; k += NTHR) {
        float cA, cB = 0.f, cC = 0.f, cD = 0.f, cE = 0.f;
        const float* PAR = (const float*)(ws + WS_PAR);
        if (MODE == 3) { cA = PAR[PAR_FNG + k]; cE = MOD[((size_t)(3 * NB + b)) * 6144 + 5120 + k]; }
        else {
            const float* m = MOD + ((size_t)(layer * NB + b)) * 6144;
            if (MODE == 2) {
                cA = PAR[PAR_NG + (layer * 2 + 1) * D + k] * (1.0f + m[4096 + k]); cB = m[3072 + k];
                const float g1 = m[2048 + k];
                if (pool) { const float ps = PAR[PAR_PS + j2 * D + k], pb = PAR[PAR_PB + j2 * D + k]; cC = g1 * ps; cD = g1 * pb * ps; } else { cC = g1; cD = 0.f; }
            } else {
                cA = PAR[PAR_NG + (layer * 2 + 0) * D + k] * (1.0f + m[1024 + k]); cB = m[k];
                if (layer > 0) cE = MOD[((size_t)((layer - 1) * NB + b)) * 6144 + 5120 + k];
            }
        }
        coef[k] = cA; coef[1024 + k] = cB; coef[2048 + k] = cC; coef[3072 + k] = cD; coef[4096 + k] = cE;
    }
    if (MODE == 2 && tid < 64) ((LAS int*)(lds + TK_HIST))[tid] = 0;
    __syncthreads();
    const bf16_t* WH = nullptr; const bf16_t* WL = nullptr;
    if (MODE == 2) { WH = (const bf16_t*)(ws + WS_WR) + (size_t)(layer * 2 + 0) * NRT * D; WL = (const bf16_t*)(ws + WS_WR) + (size_t)(layer * 2 + 1) * NRT * D; }
    if (MODE == 1) { WH = (const bf16_t*)(ws + WS_WZ) + (size_t)(j2 * 2 + 0) * 16 * D; WL = (const bf16_t*)(ws + WS_WZ) + (size_t)(j2 * 2 + 1) * 16 * D; }
    constexpr int NCTW = (MODE == 2) ? 5 : 1;
    bf16x8 WRh[4][NCTW], WRl[4][NCTW];
    if (MODE == 1 || MODE == 2) {
#pragma unroll
        for (int ks = 0; ks < 4; ++ks)
#pragma unroll
            for (int ct = 0; ct < NCTW; ++ct) { const size_t fo = ((size_t)((w * 4 + ks) * NCTW + ct) * 64 + lane) * 8; WRh[ks][ct] = *(const bf16x8*)(WH + fo); if (MODE == 1 || ROUTER_SPLIT) WRl[ks][ct] = *(const bf16x8*)(WL + fo); else WRl[ks][ct] = WRh[ks][ct]; }
    }
    if (MODE == 0 && (tok0 & (SEQ - 1)) != 0) {
#pragma unroll 1
        for (int i = w + 1; i < 16; i += 8) { tk_issue<MODE, FROM_IN>(RB[0], p, layer, tok0 - 16 + i, lane); tk_row<MODE, FROM_IN>(RB[0], p, wso, lds, layer, tok0 - 16 + i, i, lane, false); }
    }
#pragma unroll 1
    for (int tile = 0; tile < 8; tile += 2) {
#pragma unroll
        for (int q = 0; q < 2; ++q) tk_issue<MODE, FROM_IN>(RB[q], p, layer, tok0 + (tile + 1) * 16 + 2 * w + q, lane);
        tk_tile<MODE, FROM_IN>(RA, p, wso, lds, layer, tok0, tile, tid, lane, w, WRh, WRl);
        if (tile + 2 < 8) {
#pragma unroll
            for (int q = 0; q < 2; ++q) tk_issue<MODE, FROM_IN>(RA[q], p, layer, tok0 + (tile + 2) * 16 + 2 * w + q, lane);
        }
        tk_tile<MODE, FROM_IN>(RB, p, wso, lds, layer, tok0, tile + 1, tid, lane, w, WRh, WRl);
    }
    if (MODE == 2) {
        unsigned* cntw = (unsigned*)(ws + WS_CTL) + CW_CNT + layer * 64 * 16;
        LAS int* hist = (LAS int*)(lds + TK_HIST); LAS int* base = (LAS int*)(lds + TK_BASE);
        __syncthreads();
        if (tid < 64) { const int h = hist[tid]; base[tid] = (h > 0 && !dry) ? (int)atomicAdd(cntw + tid * 16, (unsigned)h) : 0; }
        __syncthreads();
        if (tid < 256) {
            const int e = ((LAS int*)(lds + TK_AE))[tid]; const int pos = base[e] + ((LAS int*)(lds + TK_AR))[tid];
            u32x2 ent; ent.x = (unsigned)(tok0 * 2 + tid); ent.y = __builtin_bit_cast(unsigned, ((LAS float*)(lds + TK_AW))[tid]);
            *(u32x2*)(wso + WS_LIST + ((size_t)e * LISTCAP + (size_t)pos) * 8) = ent;
        }
    }
    __syncthreads();
}

__device__ __forceinline__ void gla_g4(const Params& p, int layer) {
    int tid = threadIdx.x; asm volatile("" : "+v"(tid));
    const int lane = tid & 63, w = tid >> 6; const int j2 = layer >> 1;
    unsigned char* ws = p.ws;
    const bf16_t* OB = (const bf16_t*)(ws + WS_O); const bf16_t* PR = (const bf16_t*)(ws + WS_PROJ); bf16_t* AB = (bf16_t*)(ws + WS_A);
    const f32x4 ng = ((const f32x4*)((const float*)(ws + WS_PAR) + PAR_GNG + j2 * HV))[lane];
    const int tok0 = blockIdx.x * 128 + w * 16;
    for (int i = 0; i < 16; ++i) {
        const int t = tok0 + i;
#pragma unroll
        for (int j = 0; j < 4; ++j) {
            const u32x2 ow = __builtin_nontemporal_load((const u32x2*)(OB + (size_t)t * D) + 64 * j + lane), rw = __builtin_nontemporal_load((const u32x2*)(PR + (size_t)t * NPROJ + 2048) + 64 * j + lane);
            const f32x4 o = (f32x4){bflo(ow.x), bfhi(ow.x), bflo(ow.y), bfhi(ow.y)}, r = (f32x4){bflo(rw.x), bfhi(rw.x), bflo(rw.y), bfhi(rw.y)};
            float ss = (o[0] * o[0] + o[1] * o[1]) + (o[2] * o[2] + o[3] * o[3]);
            ss = wave_sum(ss);
            const float rs = 1.0f / sqrtf(ss * (1.0f / HV) + EPS);
            f32x4 a;
#pragma unroll
            for (int e = 0; e < 4; ++e) a[e] = o[e] * rs * ng[e] * (r[e] / (1.0f + __expf(-r[e])));
            u32x2 out; out.x = pk2(a[0], a[1]); out.y = pk2(a[2], a[3]);
            if (G5_FP8) ((unsigned*)((unsigned char*)AB + (size_t)t * D))[64 * j + lane] = pk4_fp8(a[0], a[1], a[2], a[3]);
            else ((u32x2*)(AB + (size_t)t * D))[64 * j + lane] = out;
        }
    }
}

constexpr int GA_ZT = 0, GA_SEG = 4096, GA_QE = 6144, GA_KE = 23552, GA_Q = 40960, GA_K = 58368, GA_WG = 75776, GA_BG = 108544;
struct G3aRegs { u32x4 q[2], k[2]; f32x4 z; };
__device__ __forceinline__ void g3a_load(G3aRegs& R, const unsigned char* ws, int it, int tid) {
    const int hd = it & 3, n = (it >> 2) & 63, b = it >> 8, t0 = b * SEQ + n * CH;
    const bf16_t* PR = (const bf16_t*)(ws + WS_PROJ);
#pragma unroll
    for (int q = 0; q < 2; ++q) { const int pi = tid + 512 * q; const bf16_t* rp = PR + (size_t)(t0 + (pi >> 4)) * NPROJ + hd * HK + 8 * (pi & 15); R.q[q] = __builtin_nontemporal_load((const u32x4*)rp); R.k[q] = __builtin_nontemporal_load((const u32x4*)(rp + GK)); }
    R.z = tid < 256 ? ((const f32x4*)((const float*)(ws + WS_Z) + (size_t)t0 * 16))[tid] : (f32x4){0.f, 0.f, 0.f, 0.f};
}
__device__ __forceinline__ void gla_g3a(const Params& p, LAS unsigned char* lds, int layer) {
    int tid = threadIdx.x; asm volatile("" : "+v"(tid));
    const int lane = tid & 63, w = tid >> 6, d = tid & 127, seg = tid >> 7; const int j2 = layer >> 1;
    unsigned char* ws = p.ws;
    LAS float* ZT = (LAS float*)(lds + GA_ZT); LAS float* SEGT = (LAS float*)(lds + GA_SEG); LAS unsigned char* QEs = lds + GA_QE; LAS unsigned char* KEs = lds + GA_KE;
    G3aRegs R; g3a_load(R, ws, blockIdx.x * 8, tid);
    {
        float t[16];
#pragma unroll
        for (int i = 0; i < 16; ++i) t[i] = ((const float*)(ws + WS_PAR))[PAR_GWG + j2 * 16 * GK + tid + i * NTHR];
#pragma unroll
        for (int i = 0; i < 16; ++i) ((LAS float*)(lds + GA_WG))[tid + i * NTHR] = t[i] * LOG2E;
    }
    ((LAS float*)(lds + GA_BG))[tid] = ((const float*)(ws + WS_PAR))[PAR_GBG + j2 * GK + tid] * LOG2E;
#pragma unroll 1
    for (int ii = 0; ii < 8; ++ii) {
        const int it = blockIdx.x * 8 + ii, hd = it & 3;
#pragma unroll
        for (int q = 0; q < 2; ++q) { const int pi = tid + 512 * q; *(LAS u32x4*)(lds + GA_Q + (pi >> 4) * 272 + (pi & 15) * 16) = R.q[q]; *(LAS u32x4*)(lds + GA_K + (pi >> 4) * 272 + (pi & 15) * 16) = R.k[q]; }
        if (tid < 256) ((LAS f32x4*)ZT)[tid] = R.z;
        __syncthreads();
        if (ii + 1 < 8) g3a_load(R, ws, it + 1, tid);
        f32x2 wg[8];
#pragma unroll
        for (int j = 0; j < 8; ++j) wg[j] = (f32x2){((const LAS float*)(lds + GA_WG))[(2 * j) * GK + hd * HK + d], ((const LAS float*)(lds + GA_WG))[(2 * j + 1) * GK + hd * HK + d]};
        const float bg = ((const LAS float*)(lds + GA_BG))[hd * HK + d];
        float bc[16]; float run = 0.f;
#pragma unroll
        for (int r = 0; r < 16; ++r) {
            const LAS f32x4* zr = (const LAS f32x4*)(ZT + (16 * seg + r) * 16);
            f32x2 a2 = (f32x2){bg, 0.f};
#pragma unroll
            for (int q4 = 0; q4 < 4; ++q4) { const f32x4 z = zr[q4]; a2 = (f32x2){z[0], z[1]} * wg[2 * q4] + a2; a2 = (f32x2){z[2], z[3]} * wg[2 * q4 + 1] + a2; }
            const float pre = a2[0] + a2[1];
            const float ls = fminf(pre, 0.f) - __builtin_amdgcn_logf(1.0f + __builtin_amdgcn_exp2f(-fabsf(pre)));
            run += ls * (1.0f / 16.0f); bc[r] = run;
        }
        SEGT[seg * 128 + d] = run;
        __syncthreads();
        const float s0 = SEGT[d], s1 = SEGT[128 + d], s2 = SEGT[256 + d], s3 = SEGT[384 + d];
        const float prefix = (seg > 0 ? s0 : 0.f) + (seg > 1 ? s1 : 0.f) + (seg > 2 ? s2 : 0.f), total = (s0 + s1) + (s2 + s3);
        const float et = __builtin_amdgcn_exp2f(total);
        unsigned kdv[8];
#pragma unroll
        for (int r = 0; r < 16; ++r) {
            const int i = 16 * seg + r;
            const float q = bf2f(*(const LAS bf16_t*)(lds + GA_Q + i * 272 + d * 2)), k = bf2f(*(const LAS bf16_t*)(lds + GA_K + i * 272 + d * 2));
            const float bcum = bc[r] + prefix;
            const float qe = q * __builtin_amdgcn_exp2f(bcum) * 0.08838834764831845f, ke = k * __builtin_amdgcn_exp2f(-bcum), kd = ke * et;
            *(LAS bf16_t*)(QEs + i * 272 + d * 2) = (bf16_t)f2bf(qe);
            *(LAS bf16_t*)(KEs + i * 272 + d * 2) = (bf16_t)f2bf(ke);
            const unsigned kb = f2bf(kd);
            if (r & 1) kdv[r >> 1] |= kb << 16; else kdv[r >> 1] = kb;
        }
        {
            bf16_t* kf = (bf16_t*)(ws + WS_FRAG + (size_t)it * FRAG_ITEM + FRAG_K) + (size_t)(((d >> 4) * 2 + (seg >> 1)) * 64) * 8;
            *(u32x4*)(kf + (16 * ((2 * seg + 0) & 3) + (d & 15)) * 8) = (u32x4){kdv[0], kdv[1], kdv[2], kdv[3]};
            *(u32x4*)(kf + (16 * ((2 * seg + 1) & 3) + (d & 15)) * 8) = (u32x4){kdv[4], kdv[5], kdv[6], kdv[7]}; }
        if (seg == 0) ((float*)(ws + WS_FRAG + (size_t)it * FRAG_ITEM + FRAG_D))[d] = et;
        __syncthreads();
#pragma unroll
        for (int q = 0; q < 2; ++q) { const int pi = tid + 512 * q, fi = pi >> 8, ks = (pi >> 6) & 3, lf = pi & 63;
            *(u32x4*)((bf16_t*)(ws + WS_FRAG + (size_t)it * FRAG_ITEM + FRAG_Q) + (size_t)pi * 8) = *(const LAS u32x4*)(QEs + (16 * fi + (lf & 15)) * 272 + (32 * ks + 8 * (lf >> 4)) * 2); }
        const int it_ = w >> 1;
#pragma unroll
        for (int q = 0; q < 2; ++q) {
            const int jt = 2 * (w & 1) + q;
            f32x4 acc = (f32x4){0.f, 0.f, 0.f, 0.f};
            if (jt <= it_) {
#pragma unroll
                for (int ks = 0; ks < 4; ++ks) {
                    const int kk = 32 * ks + 8 * (lane >> 4);
                    const bf16x8 fk = *(const LAS bf16x8*)(KEs + (16 * jt + (lane & 15)) * 272 + kk * 2);
                    const bf16x8 fq = *(const LAS bf16x8*)(QEs + (16 * it_ + (lane & 15)) * 272 + kk * 2);
                    acc = __builtin_amdgcn_mfma_f32_16x16x32_bf16(fk, fq, acc, 0, 0, 0);
                }
            }
            const int i = 16 * it_ + (lane & 15), jb = 16 * jt + 4 * (lane >> 4);
            float v[4];
#pragma unroll
            for (int r = 0; r < 4; ++r) v[r] = (jb + r <= i) ? acc[r] : 0.f;
            u32x2 o; o.x = pk2(v[0], v[1]); o.y = pk2(v[2], v[3]);
            *(u32x2*)((bf16_t*)(ws + WS_FRAG + (size_t)it * FRAG_ITEM + FRAG_P) + (size_t)(((it_ * 2 + (jt >> 1)) * 64 + 16 * ((2 * jt + (lane >> 5)) & 3) + (lane & 15)) * 8 + 4 * ((lane >> 4) & 1))) = o;
        }
        __syncthreads();
    }
}

constexpr int G3_VT = 0, G3_ST = 4608, G3_RT = 13312, G3_SET = 17408;
struct G3Regs { u32x4 f[6]; u32x4 vr; };
__device__ __forceinline__ void g3_load(G3Regs& R, const unsigned char* ws, unsigned of, unsigned orr, unsigned ovv, int b, int hd, int n, int w) {
    const int item = (b * NCH + n) * NH + hd, t0 = b * SEQ + n * CH;
    const unsigned char* fb = ws + WS_FRAG + (size_t)item * FRAG_ITEM;
    const unsigned char* pr = ws + WS_PROJ + (size_t)t0 * NPROJ * 2;
    if (w < 4) {
        const u32x4* pf = (const u32x4*)(fb + FRAG_P + w * 2048 + of);
        const u32x4* qf = (const u32x4*)(fb + FRAG_Q + w * 4096 + of);
        R.f[0] = pf[0]; R.f[1] = pf[64]; R.f[2] = qf[0]; R.f[3] = qf[64]; R.f[4] = qf[128]; R.f[5] = qf[192];
    } else {
        const u32x4* kf = (const u32x4*)(fb + FRAG_K + (w - 4) * 4096 + of);
        const u32x4* dc = (const u32x4*)(fb + FRAG_D + (w - 4) * 128 + orr);
        R.f[0] = kf[0]; R.f[1] = kf[64]; R.f[2] = kf[128]; R.f[3] = kf[192]; R.f[4] = dc[0]; R.f[5] = dc[4];
    }
    R.vr = *(const u32x4*)(pr + ovv);
}
__device__ __forceinline__ bf16x8 asbf(u32x4 v) { return __builtin_bit_cast(bf16x8, v); }
typedef short s16x4 __attribute__((ext_vector_type(4)));
__device__ __forceinline__ bf16x8 g3_vfrag(LAS unsigned char* p) {
    const s16x4 a = __builtin_amdgcn_ds_read_tr16_b64_v4i16((LAS s16x4*)p), b = __builtin_amdgcn_ds_read_tr16_b64_v4i16((LAS s16x4*)(p + 256));
    return __builtin_shufflevector(a, b, 0, 1, 2, 3, 4, 5, 6, 7);
}
__device__ __forceinline__ void g3_step(G3Regs& R, unsigned of, unsigned orr, unsigned ovv, unsigned bvt, LAS unsigned char* sb, f32x4 (&S)[2][2], LAS const unsigned char* ngl, unsigned char* ws, int b, int hd, int vs, int n, int tid, int lane, int w) {
    if ((tid & 7) < 4) *(LAS u32x4*)(sb + G3_VT + (tid >> 3) * 64 + (((2 * (tid & 7)) ^ (4 * (w & 1))) * 8)) = R.vr;
    else *(LAS u32x4*)(sb + G3_RT + (tid >> 3) * 64 + ((tid & 7) - 4) * 16) = R.vr;
    if (w >= 4) {
#pragma unroll
        for (int dtl = 0; dtl < 2; ++dtl)
#pragma unroll
            for (int vt = 0; vt < 2; ++vt) { u32x2 a; a.x = pk2(S[dtl][vt][0], S[dtl][vt][1]); a.y = pk2(S[dtl][vt][2], S[dtl][vt][3]);
                *(LAS u32x2*)(sb + G3_ST + (16 * vt + (lane & 15)) * 272 + (16 * (2 * (w - 4) + dtl) + 4 * (lane >> 4)) * 2) = a; }
    }
    __syncthreads();
    const G3Regs& C = R;
    const int t0 = b * SEQ + n * CH;
    if (w < 4) {
        float ssq = 0.f; unsigned pk0 = 0u;
        const u32x4 rx = *(const LAS u32x4*)(sb + G3_RT + (16 * w + (lane & 15)) * 64 + (lane >> 4) * 16);
        bf16x8 fvv[2][2], fss[2][4];
#pragma unroll
        for (int vt = 0; vt < 2; ++vt) {
#pragma unroll
            for (int ks = 0; ks < 2; ++ks) fvv[vt][ks] = g3_vfrag(sb + G3_VT + (bvt ^ (unsigned)(8 * vt)) + 2048 * ks);
#pragma unroll
            for (int ks = 0; ks < 4; ++ks) fss[vt][ks] = *(const LAS bf16x8*)(sb + G3_ST + (16 * vt + (lane & 15)) * 272 + (32 * ks + 8 * (lane >> 4)) * 2);
        }
        f32x4 aP[2], aQ[2], aR[2];
#pragma unroll
        for (int vt = 0; vt < 2; ++vt) { aP[vt] = __builtin_amdgcn_mfma_f32_16x16x32_bf16(fvv[vt][0], asbf(C.f[0]), (f32x4){0.f, 0.f, 0.f, 0.f}, 0, 0, 0);
            aQ[vt] = __builtin_amdgcn_mfma_f32_16x16x32_bf16(fss[vt][0], asbf(C.f[2]), (f32x4){0.f, 0.f, 0.f, 0.f}, 0, 0, 0);
            aR[vt] = __builtin_amdgcn_mfma_f32_16x16x32_bf16(fss[vt][2], asbf(C.f[4]), (f32x4){0.f, 0.f, 0.f, 0.f}, 0, 0, 0); }
#pragma unroll
        for (int vt = 0; vt < 2; ++vt) { aP[vt] = __builtin_amdgcn_mfma_f32_16x16x32_bf16(fvv[vt][1], asbf(C.f[1]), aP[vt], 0, 0, 0);
            aQ[vt] = __builtin_amdgcn_mfma_f32_16x16x32_bf16(fss[vt][1], asbf(C.f[3]), aQ[vt], 0, 0, 0);
            aR[vt] = __builtin_amdgcn_mfma_f32_16x16x32_bf16(fss[vt][3], asbf(C.f[5]), aR[vt], 0, 0, 0); }
#pragma unroll
        for (int vt = 0; vt < 2; ++vt) {
            f32x4 acc = (aP[vt] + aQ[vt]) + aR[vt];
            if (FUSE_G4) {
                ssq += (acc[0] * acc[0] + acc[1] * acc[1]) + (acc[2] * acc[2] + acc[3] * acc[3]);
                u32x2 rw; rw.x = vt ? rx.z : rx.x; rw.y = vt ? rx.w : rx.y;
                const f32x4 rv = bf4(rw);
                const f32x4 ngv = *(const LAS f32x4*)(ngl + (8 * (lane >> 4) + 4 * vt) * 4);
#pragma unroll
                for (int r = 0; r < 4; ++r) acc[r] = acc[r] * ngv[r] * (rv[r] * __builtin_amdgcn_rcpf(1.0f + __expf(-rv[r])));
                if (G5_FP8) { const unsigned pk = pk4_fp8(acc[0], acc[1], acc[2], acc[3]); if (vt == 0) pk0 = pk; else *(u32x2*)(ws + WS_A + (size_t)(t0 + 16 * w + (lane & 15)) * D + hd * HV + vs * 32 + 8 * (lane >> 4)) = (u32x2){pk0, pk}; }
                else { u32x2 o; o.x = pk2(acc[0], acc[1]); o.y = pk2(acc[2], acc[3]);
                    *(u32x2*)((bf16_t*)(ws + WS_A) + (size_t)(t0 + 16 * w + (lane & 15)) * D + hd * HV + vs * 32 + 16 * vt + 4 * (lane >> 4)) = o; }
            } else {
                u32x2 o; o.x = pk2(acc[0], acc[1]); o.y = pk2(acc[2], acc[3]);
                *(u32x2*)((bf16_t*)(ws + WS_O) + (size_t)(t0 + 16 * w + (lane & 15)) * D + hd * HV + vs * 32 + 16 * vt + 4 * (lane >> 4)) = o;
            }
        }
        if (FUSE_G4) { ssq = xsum32(ssq); ssq += __shfl_xor(ssq, 16);
            if (lane < 16) ((float*)(ws + WS_O))[(size_t)(hd * 8 + vs) * T + t0 + 16 * w + lane] = ssq; }
    } else {
#pragma unroll
        for (int dtl = 0; dtl < 2; ++dtl) {
            const f32x4 dec = __builtin_bit_cast(f32x4, C.f[4 + dtl]);
#pragma unroll
            for (int vt = 0; vt < 2; ++vt) {
                f32x4 u = (f32x4){0.f, 0.f, 0.f, 0.f};
#pragma unroll
                for (int ks = 0; ks < 2; ++ks) { const bf16x8 fb = g3_vfrag(sb + G3_VT + (bvt ^ (unsigned)(8 * vt)) + 2048 * ks);
                    u = __builtin_amdgcn_mfma_f32_16x16x32_bf16(asbf(C.f[dtl * 2 + ks]), fb, u, 0, 0, 0); }
                S[dtl][vt] = dec * S[dtl][vt] + u;
            }
        }
    }
    g3_load(R, ws, of, orr, ovv, b, hd, n + 4 < NCH ? n + 4 : NCH - 1, w);
}
__device__ __forceinline__ void gla_g3b(const Params& p, LAS unsigned char* lds, int layer) {
    int tid = threadIdx.x; asm volatile("" : "+v"(tid));
    const int lane = tid & 63, w = __builtin_amdgcn_readfirstlane(tid >> 6);
    const int c = blockIdx.x, gi = c & 31, vs = c >> 5, b = gi >> 2, hd = gi & 3;
    unsigned char* ws = p.ws;
    f32x4 S[2][2];
#pragma unroll
    for (int i = 0; i < 2; ++i)
#pragma unroll
        for (int j = 0; j < 2; ++j) S[i][j] = (f32x4){0.f, 0.f, 0.f, 0.f};
    const bool leader = (vs == 0);
    LAS unsigned char* ngl = lds + 2 * G3_SET;
    if (tid < 32) ((LAS float*)ngl)[tid] = ((const float*)(ws + WS_PAR))[PAR_GNG + (layer >> 1) * HV + vs * 32 + tid];
    G3Regs RA, RB, RC, RD;
    const unsigned of = (unsigned)lane * 16u, orr = w < 4 ? (unsigned)(((16 * w + (lane & 15)) * NPROJ + 2048 + hd * HV + vs * 32 + 8 * (lane >> 4)) * 2) : (unsigned)(16 * (lane >> 4)),
                   ovv = (unsigned)(((tid >> 3) * NPROJ + 1024 + (hd * 8 + vs) * 64 + (tid & 7) * 8) * 2);
    const unsigned bvt = (unsigned)((8 * (lane >> 4) + ((lane & 15) >> 2)) * 64 + (((2 * (lane & 3)) ^ (4 * ((lane >> 4) & 1))) * 8));
    g3_load(RA, ws, of, orr, ovv, b, hd, 0, w); g3_load(RB, ws, of, orr, ovv, b, hd, 1, w); g3_load(RC, ws, of, orr, ovv, b, hd, 2, w);
    g3_load(RD, ws, of, orr, ovv, b, hd, 3, w);
#pragma unroll 1
    for (int n = 0; n < NCH; n += 4) {
        g3_step(RA, of, orr, ovv, bvt, lds, S, ngl, ws, b, hd, vs, n, tid, lane, w);
        g3_step(RB, of, orr, ovv, bvt, lds + G3_SET, S, ngl, ws, b, hd, vs, n + 1, tid, lane, w);
        g3_step(RC, of, orr, ovv, bvt, lds, S, ngl, ws, b, hd, vs, n + 2, tid, lane, w);
        g3_step(RD, of, orr, ovv, bvt, lds + G3_SET, S, ngl, ws, b, hd, vs, n + 3, tid, lane, w);
    }
    __syncthreads();
}

struct P0Item { const float* W; bf16_t* WT; int Nstride, drow, Kdst, k0, n0, fp8; };
__device__ __forceinline__ bool p0_item(const Params& p, int it, P0Item& o) {
    constexpr int I_A = M1_FP8 ? 0 : 256 * 384, I_B = M2_FP8 ? 0 : 256 * 192, I_C2 = 2 * 1536, I_D = G5_FP8 ? 0 : 2 * 512, I_E = 8 * 32;
    unsigned char* ws = p.ws; int r = it; if (r < 0) return false;
    if (r < I_A) { const int mat = r / 384, q = r % 384, kb = q / 24, nb = q % 24, n0 = nb * 32;
        o.W = p.in[I_MWI] + (size_t)mat * D * 768; o.WT = (bf16_t*)(ws + WS_WMI + (size_t)mat * 768 * D * (M1_FP8 ? 1 : 2)); o.Nstride = 768; o.Kdst = D; o.k0 = kb * 64; o.n0 = n0; o.fp8 = M1_FP8;
        o.drow = n0 < FF ? (256 * (n0 / 128) + (n0 % 128)) : (256 * ((n0 - FF) / 128) + 128 + ((n0 - FF) % 128)); return true; }
    r -= I_A;
    if (r < I_B) { const int mat = r / 192, q = r % 192, kb = q / 32, nb = q % 32;
        o.fp8 = M2_FP8 ? 2 : 0; o.W = p.in[I_MWO] + (size_t)mat * FF * D; o.WT = (bf16_t*)(ws + WS_WMO + (size_t)mat * D * (M2_FP8 ? 512 : FF * 2)); o.Nstride = D; o.Kdst = M2_FP8 ? 512 : FF; o.k0 = kb * 64; o.n0 = nb * 32; o.drow = nb * 32; return true; }
    r -= I_B;
    if (r < I_C2) { const int mat = r / 1536, q = r % 1536, kb = q / 96, nb = q % 96;
        o.fp8 = G2_FP8 ? 1 : 0; o.W = p.in[I_GWIN] + (size_t)mat * D * GIN; o.WT = (bf16_t*)(ws + WS_WGI + (size_t)mat * NPROJ * D * (G2_FP8 ? 1 : 2)); o.Nstride = GIN; o.Kdst = D; o.k0 = kb * 64; o.n0 = nb * 32; o.drow = nb < 32 ? nb * 32 : 1024 + (nb < 64 ? (nb - 32) * 64 : (nb - 64) * 64 + 32);
        if (G2_VR8) { const bool vr = nb >= 32;
            o.fp8 = vr ? 1 : 0; o.WT = (bf16_t*)(ws + WS_WGI + (vr ? 4 * MiB : 0) + (size_t)mat * 2 * MiB); o.drow = vr ? (nb < 64 ? (nb - 32) * 64 : (nb - 64) * 64 + 32) : nb * 32; }
        return true; }
    r -= I_C2;
    if (r < I_D) { const int mat = r / 512, q = r % 512, kb = q / 32, nb = q % 32;
        o.fp8 = G5_FP8 ? 1 : 0; o.W = p.in[I_GWO] + (size_t)mat * D * D; o.WT = (bf16_t*)(ws + WS_WGO + (size_t)mat * D * D * (G5_FP8 ? 1 : 2)); o.Nstride = D; o.Kdst = D; o.k0 = kb * 64; o.n0 = nb * 32; o.drow = nb * 32; return true; }
    r -= I_D;
    if (r < I_E) { const int mat = r / 32, q = r % 32, kb = q / 8, nb = q % 8;
        o.fp8 = 0; o.W = p.in[I_PW] + (size_t)mat * 256 * 256; o.WT = (bf16_t*)(ws + WS_WPL) + (size_t)mat * 256 * 256; o.Nstride = 256; o.Kdst = 256; o.k0 = kb * 64; o.n0 = nb * 32; o.drow = nb * 32; return true; }
    return false;
}
__device__ __forceinline__ void p0_load(const P0Item& o, float (&v)[32], int lane) {
#pragma unroll
    for (int i = 0; i < 8; ++i) { const f32x4 t = __builtin_nontemporal_load((const f32x4*)(o.W + (size_t)(o.k0 + 8 * i + (lane >> 3)) * o.Nstride + o.n0 + 4 * (lane & 7))); v[4 * i] = t[0]; v[4 * i + 1] = t[1]; v[4 * i + 2] = t[2]; v[4 * i + 3] = t[3]; }
}
__device__ __forceinline__ void p0_emit(const P0Item& o, const float (&v)[32], LAS float* scr, int lane) {
#pragma unroll
    for (int i = 0; i < 8; ++i)
#pragma unroll
        for (int e = 0; e < 4; ++e) scr[(8 * i + (lane >> 3)) * 33 + 4 * (lane & 7) + e] = v[4 * i + e];
    LDS_WAIT(); asm volatile("" ::: "memory");
    const int c = lane & 7;
#pragma unroll
    for (int j = 0; j < 4; ++j) { const int n = (lane >> 3) + 8 * j; const LAS float* s = scr + (8 * c) * 33 + n;
        if (o.fp8) { const float sc = o.fp8 == 1 ? 32.f : 16.f;
            u32x2 w8; w8.x = pk4_fp8(s[0 * 33] * sc, s[1 * 33] * sc, s[2 * 33] * sc, s[3 * 33] * sc); w8.y = pk4_fp8(s[4 * 33] * sc, s[5 * 33] * sc, s[6 * 33] * sc, s[7 * 33] * sc);
            unsigned char* dp = (unsigned char*)o.WT + (size_t)(o.drow + n) * o.Kdst;
            *(u32x2*)(dp + o.k0 + 8 * c) = w8;
            if (o.fp8 == 2 && o.k0 == 320) { *(u32x2*)(dp + 384 + 8 * c) = (u32x2){0u, 0u}; *(u32x2*)(dp + 448 + 8 * c) = (u32x2){0u, 0u}; } }
        else { u32x4 w; w.x = pk2(s[0 * 33], s[1 * 33]); w.y = pk2(s[2 * 33], s[3 * 33]); w.z = pk2(s[4 * 33], s[5 * 33]); w.w = pk2(s[6 * 33], s[7 * 33]);
            *(u32x4*)(o.WT + (size_t)(o.drow + n) * o.Kdst + o.k0 + 8 * c) = w; } }
    LDS_WAIT(); asm volatile("" ::: "memory");
}
struct P8Item { const float* W; unsigned char* WT; int Nstride, drow, Kdst, k0, n0, kind; };
constexpr int P8_A = M1_FP8 ? 256 * 8 * 24 : 0, P8_B = M2_FP8 ? 256 * 3 * 32 : 0, P8_D = G5_FP8 ? 2 * 8 * 32 : 0;
template <int WHICH>
__device__ __forceinline__ bool p8_item(const Params& p, int r, P8Item& o) {
    unsigned char* ws = p.ws;
    if (WHICH == 0) { if (r >= P8_A) return false; const int mat = r / 192, q = r % 192, kb = q / 24, nb = q % 24, n0 = nb * 32;
        o.W = p.in[I_MWI] + (size_t)mat * D * 768; o.WT = ws + WS_WMI + (size_t)mat * 768 * D; o.Nstride = 768; o.Kdst = D; o.k0 = kb * 128; o.n0 = n0; o.kind = 3;
        o.drow = n0 < FF ? (256 * (n0 / 128) + (n0 % 128)) : (256 * ((n0 - FF) / 128) + 128 + ((n0 - FF) % 128)); return true; }
    if (WHICH == 1) { if (r >= P8_B) return false; const int mat = r / 96, q = r % 96, kb = q / 32, nb = q % 32;
        o.W = p.in[I_MWO] + (size_t)mat * FF * D; o.WT = ws + WS_WMO + (size_t)mat * D * 512; o.Nstride = D; o.Kdst = 512; o.k0 = kb * 128; o.n0 = nb * 32; o.drow = nb * 32; o.kind = 2; return true; }
    if (r >= P8_D) return false; const int mat = r / 256, q = r % 256, kb = q / 32, nb = q % 32;
    o.W = p.in[I_GWO] + (size_t)mat * D * D; o.WT = ws + WS_WGO + (size_t)mat * D * D; o.Nstride = D; o.Kdst = D; o.k0 = kb * 128; o.n0 = nb * 32; o.drow = nb * 32; o.kind = 1; return true;
}
__device__ __forceinline__ void p8_load(const P8Item& o, f32x4 (&v)[16], int lane) {
#pragma unroll
    for (int i = 0; i < 16; ++i) v[i] = __builtin_nontemporal_load((const f32x4*)(o.W + (size_t)(o.k0 + 8 * i + (lane >> 3)) * o.Nstride + o.n0 + 4 * (lane & 7)));
}
template <int WHICH>
__device__ __forceinline__ void p8_emit(const P8Item& o, const f32x4 (&v)[16], LAS float* scr, int lane) {
#pragma unroll
    for (int i = 0; i < 16; ++i)
#pragma unroll
        for (int e = 0; e < 4; ++e) scr[(8 * i + (lane >> 3)) * 33 + 4 * (lane & 7) + e] = v[i][e];
    LDS_WAIT(); asm volatile("" ::: "memory");
    const int c = lane & 7; const float sc = WHICH == 2 ? 32.f : (WHICH == 1 ? 16.f : (o.n0 < FF ? 32.f * LOG2E : 256.f / LOG2E));
#pragma unroll
    for (int j = 0; j < 4; ++j) { const int n = (lane >> 3) + 8 * j; const LAS float* s = scr + (16 * c) * 33 + n;
        u32x4 w;
        w.x = pk4_fp8(s[0 * 33] * sc, s[1 * 33] * sc, s[2 * 33] * sc, s[3 * 33] * sc); w.y = pk4_fp8(s[4 * 33] * sc, s[5 * 33] * sc, s[6 * 33] * sc, s[7 * 33] * sc);
        w.z = pk4_fp8(s[8 * 33] * sc, s[9 * 33] * sc, s[10 * 33] * sc, s[11 * 33] * sc); w.w = pk4_fp8(s[12 * 33] * sc, s[13 * 33] * sc, s[14 * 33] * sc, s[15 * 33] * sc);
        unsigned char* dp = o.WT + (size_t)(o.drow + n) * o.Kdst;
        *(u32x4*)(dp + o.k0 + 16 * c) = w;
        }
    LDS_WAIT(); asm volatile("" ::: "memory");
}
__device__ __forceinline__ void p0_prologue(const Params& p, LAS unsigned char* lds) {
    int tid = threadIdx.x; asm volatile("" : "+v"(tid));
    const int lane = tid & 63, w = __builtin_amdgcn_readfirstlane(tid >> 6), c = blockIdx.x, G = gridDim.x;
    unsigned char* ws = p.ws;
    for (int item = c; item < 192; item += G) {
        const int l = item / 48, ch = item % 48;
        LAS float* SC = (LAS float*)lds; LAS float* RED = (LAS float*)(lds + 32768);
        __syncthreads();
        for (int idx = tid; idx < NB * D; idx += NTHR) { const int bb = idx >> 10, k = idx & 1023; const float v = p.in[I_C][idx]; SC[k * 8 + bb] = v / (1.0f + __expf(-v)); }
        __syncthreads();
        float a0[8], a1[8];
#pragma unroll
        for (int bb = 0; bb < 8; ++bb) { a0[bb] = 0.f; a1[bb] = 0.f; }
        const float* wp = p.in[I_WMOD] + ((size_t)l * D + 128 * w) * 6144 + ch * 128 + 2 * lane;
#pragma unroll 8
        for (int kk = 0; kk < 128; ++kk) {
            const f32x2 wv = *(const f32x2*)(wp + (size_t)kk * 6144);
            const LAS f32x4* s = (const LAS f32x4*)(SC + (128 * w + kk) * 8);
            const f32x4 sa = s[0], sb = s[1];
            a0[0] += sa[0] * wv[0]; a1[0] += sa[0] * wv[1]; a0[1] += sa[1] * wv[0]; a1[1] += sa[1] * wv[1];
            a0[2] += sa[2] * wv[0]; a1[2] += sa[2] * wv[1]; a0[3] += sa[3] * wv[0]; a1[3] += sa[3] * wv[1];
            a0[4] += sb[0] * wv[0]; a1[4] += sb[0] * wv[1]; a0[5] += sb[1] * wv[0]; a1[5] += sb[1] * wv[1];
            a0[6] += sb[2] * wv[0]; a1[6] += sb[2] * wv[1]; a0[7] += sb[3] * wv[0]; a1[7] += sb[3] * wv[1];
        }
#pragma unroll
        for (int bb = 0; bb < 8; ++bb) { RED[(w * 8 + bb) * 128 + 2 * lane] = a0[bb]; RED[(w * 8 + bb) * 128 + 2 * lane + 1] = a1[bb]; }
        __syncthreads();
        for (int idx = tid; idx < 8 * 128; idx += NTHR) {
            const int bb = idx >> 7, cc = idx & 127; float s = 0.f;
#pragma unroll
            for (int ww = 0; ww < 8; ++ww) s += RED[(ww * 8 + bb) * 128 + cc];
            ((float*)(ws + WS_MOD))[((size_t)(l * NB + bb)) * 6144 + ch * 128 + cc] = s + p.in[I_BMOD][l * 6144 + ch * 128 + cc];
        }
        __syncthreads();
    }
    {
        float* PAR = (float*)(ws + WS_PAR);
        const int idx = c * NTHR + tid;
        if (idx < 8192) PAR[PAR_NG + idx] = p.in[I_NG][idx];
        else if (idx < 8192 + 2048) PAR[PAR_PB + idx - 8192] = p.in[I_PB][idx - 8192];
        else if (idx < 8192 + 4096) PAR[PAR_PS + idx - 10240] = p.in[I_PS][idx - 10240];
        else if (idx < 12288 + 16384) PAR[PAR_GWG + idx - 12288] = p.in[I_GWG][idx - 12288];
        else if (idx < 28672 + 1024) PAR[PAR_GBG + idx - 28672] = p.in[I_GBG][idx - 28672];
        else if (idx < 29696 + 1024) PAR[PAR_FNG + idx - 29696] = p.in[I_FNG][idx - 29696];
        else if (idx < 30720 + 512) PAR[PAR_GNG + idx - 30720] = p.in[I_GNG][idx - 30720];
        else if (idx < 31232 + 32) PAR[PAR_MBG + idx - 31232] = p.in[I_MBG][idx - 31232];
        else if (idx < 31264 + 256) PAR[PAR_MBE + idx - 31264] = p.in[I_MBE][idx - 31264];
    }
    const int gw = c * NWAVES + w, NGW = G * NWAVES;
    for (int it = gw; it < 4 * NRT + 2 * 16; it += NGW) {
        const bool rt = it < 4 * NRT;
        const int r = rt ? it : it - 4 * NRT, set = rt ? r / NRT : r / 16, n = rt ? r % NRT : r % 16, nct = rt ? 5 : 1;
        bf16_t* hi = (bf16_t*)(ws + (rt ? WS_WR : WS_WZ)) + (size_t)(set * 2 + 0) * (rt ? NRT : 16) * D; bf16_t* lo = hi + (size_t)(rt ? NRT : 16) * D;
        float vv[16];
#pragma unroll
        for (int i = 0; i < 16; ++i) { const int k = lane + 64 * i;
            if (rt) vv[i] = n < 8 ? p.in[I_MWG][((size_t)set * D + k) * 8 + n] : (n < 72 ? p.in[I_MWE][((size_t)set * D + k) * 64 + n - 8] : 0.f);
            else vv[i] = p.in[I_GWIN][((size_t)set * D + k) * GIN + NPROJ + n]; }
#pragma unroll
        for (int i = 0; i < 16; ++i) { const int k = lane + 64 * i; const float v = vv[i];
            const int ww = k >> 7, ks = (k >> 5) & 3, q = (k >> 3) & 3, j = k & 7, ct = n >> 4, ln = q * 16 + (n & 15);
            const size_t fo = ((size_t)((ww * 4 + ks) * nct + ct) * 64 + ln) * 8 + j;
            const unsigned h = f2bf(v); hi[fo] = (bf16_t)h; lo[fo] = (bf16_t)f2bf(v - bf2f(h));
        }
    }
    LAS float* scr = (LAS float*)(lds + 65536 + w * 8448);
    __syncthreads();
    {
        P0Item ia, ib, ic; float va[32], vb[32], vc[32];
        int it = gw; bool ha = p0_item(p, it, ia), hb = p0_item(p, it + NGW, ib), hc;
        if (ha) p0_load(ia, va, lane);
        if (hb) p0_load(ib, vb, lane);
        while (ha) {
            hc = p0_item(p, it + 2 * NGW, ic); if (hc) p0_load(ic, vc, lane);
            p0_emit(ia, va, scr, lane);
            if (!hb) break;
            ha = p0_item(p, it + 3 * NGW, ia); if (ha) p0_load(ia, va, lane);
            p0_emit(ib, vb, scr, lane);
            if (!hc) break;
            hb = p0_item(p, it + 4 * NGW, ib); if (hb) p0_load(ib, vb, lane);
            p0_emit(ic, vc, scr, lane);
            it += 3 * NGW;
        }
    }
    __syncthreads();
    {
        LAS float* scr8 = (LAS float*)(lds + w * 16896);
#define P8_RUN(WHICH) do { P8Item ia, ib; f32x4 va[16], vb[16]; int it = gw; bool ha = p8_item<WHICH>(p, it, ia), hb; if (ha) p8_load(ia, va, lane); \
        while (ha) { hb = p8_item<WHICH>(p, it + NGW, ib); if (hb) p8_load(ib, vb, lane); p8_emit<WHICH>(ia, va, scr8, lane); if (!hb) break; \
                     it += 2 * NGW; ha = p8_item<WHICH>(p, it, ia); if (ha) p8_load(ia, va, lane); p8_emit<WHICH>(ib, vb, scr8, lane); } } while (0)
        if (P8_A) P8_RUN(0);
        if (P8_B) P8_RUN(1);
        if (P8_D) P8_RUN(2);
#undef P8_RUN
        __syncthreads();
    }
}

constexpr int PH_FINAL = 41, PH_END = 42;
__global__ void __launch_bounds__(NTHR, 2) mk_fwd(Params p) {
    extern __shared__ __attribute__((aligned(16))) unsigned char lds_raw[];
    LAS unsigned char* lds = (LAS unsigned char*)lds_raw;
    const int tid = threadIdx.x, G = gridDim.x, c = blockIdx.x;
    unsigned char* ws = p.ws;
    __builtin_amdgcn_s_setreg((0 << 11) | (23 << 6) | 1, 1);
    if (tid < 64) ((LAS unsigned*)(lds + L_MISC))[tid] = 0u;
    __syncthreads();
    XcdBarrier bar; bar.bar = (unsigned*)(ws + WS_CTL) + CW_BAR; bar.x = 0; bar.st = nullptr;
    if (p.use_bar) bar = xcd_barrier_post((unsigned*)(ws + WS_CTL) + CW_BAR, (volatile LAS unsigned*)(lds + L_MISC));
#ifndef PHMASK
#define PHMASK 0xFFFF
#endif
#define EN(bit) ((PHMASK >> (bit)) & 1)
#ifndef DUPMASK
#define DUPMASK 0
#endif
#define DUP(bit) ((DUPMASK >> (bit)) & 1)
#define RUN(pid) (p.ph_lo <= (pid) && (pid) < p.ph_hi)
#define SEAMT(ty) do { if (p.use_bar) xcd_barrier(bar); } while (0)


    if (EN(0) && RUN(0)) { p0_prologue(p, lds); SEAMT(0); if (DUP(0)) { p0_prologue(p, lds); SEAMT(0); } }

    for (int layer = 0; layer < DEPTH; ++layer) {
        const int base = 1 + 10 * layer, j2 = layer >> 1; const bool pool = (layer & 1) == 0;
        if (EN(1) && RUN(base + 0)) { if (layer == 0) token_phase<0, true>(p, lds, layer); else if (pool) token_phase<0, false>(p, lds, layer); else token_phase<1, false>(p, lds, layer); SEAMT(1);
            if (DUP(1)) { if (layer == 0) token_phase<0, true>(p, lds, layer, true); else if (pool) token_phase<0, false>(p, lds, layer, true); else token_phase<1, false>(p, lds, layer, true); SEAMT(1); } }
        if (pool) {
            if (EN(2) && RUN(base + 1)) {
#if FUSE_RES
                pg8::ResidEpi<pg8::PlainGemm, true> g; g.A = (const bf16_t*)(ws + WS_H); g.Bt = (const bf16_t*)(ws + WS_WPL) + (size_t)j2 * D * 256; g.O = nullptr; g.N = D; g.K = 256; g.lda = D; g.ldc = D; g.acol = 256; g.G = G; g.c = c;
                g.Xin = (const bf16_t*)(ws + WS_X2); g.Xout = (bf16_t*)(ws + WS_X); g.g1 = (const float*)(ws + WS_MOD) + (size_t)layer * NB * 6144 + 2048; g.ps = (const float*)(ws + WS_PAR) + PAR_PS + j2 * D; g.pb = (const float*)(ws + WS_PAR) + PAR_PB + j2 * D;
#else
                pg8::PlainGemm g{(const bf16_t*)(ws + WS_H), (const bf16_t*)(ws + WS_WPL) + (size_t)j2 * D * 256, (bf16_t*)(ws + WS_U), D, 256, D, D, 256, G, c};
#endif
                pg8::gemm_phase(lds + L_STAGE, lds + L_IDX, g); SEAMT(2); if (DUP(2)) { pg8::gemm_phase(lds + L_STAGE, lds + L_IDX, g); SEAMT(2); } }
        } else {
            if (EN(3) && RUN(base + 1)) {
#if G2_FP8
                pg8::PlainGemmF8<0x7A7A7A7A> g; g.A = (const bf16_t*)(ws + WS_H); g.Bt = (const bf16_t*)(ws + WS_WGI + (size_t)j2 * NPROJ * D); g.O = (bf16_t*)(ws + WS_PROJ); g.N = NPROJ; g.K = D / 2; g.lda = D / 2; g.ldc = NPROJ; g.acol = 0; g.G = G; g.c = c;
#else
#if G2_VR8
                pg8::PlainGemm g{(const bf16_t*)(ws + WS_H), (const bf16_t*)(ws + WS_WGI + (size_t)j2 * 2 * MiB), (bf16_t*)(ws + WS_PROJ), 1024, D, D, NPROJ, 0, G, c};
                pg8::PlainGemmF8<0x7A7A7A7A> g8; g8.A = (const bf16_t*)(ws + WS_U + 32 * MiB); g8.Bt = (const bf16_t*)(ws + WS_WGI + 4 * MiB + (size_t)j2 * 2 * MiB); g8.O = (bf16_t*)(ws + WS_PROJ) + 1024; g8.N = 2048; g8.K = D / 2; g8.lda = D / 2; g8.ldc = NPROJ; g8.acol = 0; g8.G = G; g8.c = c;
                pg8::gemm_phase(lds + L_STAGE, lds + L_IDX, g8);
#else
                pg8::PlainGemm g{(const bf16_t*)(ws + WS_H), (const bf16_t*)(ws + WS_WGI) + (size_t)j2 * NPROJ * D, (bf16_t*)(ws + WS_PROJ), NPROJ, D, D, NPROJ, 0, G, c};
#endif
#endif
                pg8::gemm_phase(lds + L_STAGE, lds + L_IDX, g); SEAMT(3); if (DUP(3)) { pg8::gemm_phase(lds + L_STAGE, lds + L_IDX, g); SEAMT(3); } }
            if (EN(4) && RUN(base + 2)) { gla_g3a(p, lds, layer); SEAMT(4); if (DUP(4)) { gla_g3a(p, lds, layer); SEAMT(4); } }
            if (EN(5) && RUN(base + 3)) { gla_g3b(p, lds, layer); SEAMT(5); if (DUP(5)) { gla_g3b(p, lds, layer); SEAMT(5); } }
            if (!FUSE_G4 && EN(6) && RUN(base + 4)) { gla_g4(p, layer); SEAMT(6); if (DUP(6)) { gla_g4(p, layer); SEAMT(6); } }
            if (EN(7) && RUN(base + 5)) {
#if FUSE_G4
#if FUSE_RES
#if G5_FP8
                pg8::ResidEpi<pg8::HeadScaleGemmF8, false> g;
#else
                pg8::ResidEpi<pg8::HeadScaleGemm, false> g;
#endif
                g.Xin = (const bf16_t*)(ws + WS_X2); g.Xout = (bf16_t*)(ws + WS_X); g.g1 = (const float*)(ws + WS_MOD) + (size_t)layer * NB * 6144 + 2048; g.ps = nullptr; g.pb = nullptr;
#else
                pg8::HeadScaleGemm g;
#endif
                g.A = (const bf16_t*)(ws + WS_A); g.Bt = (const bf16_t*)(ws + WS_WGO + (size_t)j2 * D * D * (G5_FP8 ? 1 : 2)); g.O = (bf16_t*)(ws + WS_U); g.N = D; g.K = G5_FP8 ? D / 2 : D; g.lda = g.K; g.ldc = D; g.acol = 0; g.G = G; g.c = c;
                g.tab = (const LAS float*)(lds + L_IDX);
                __syncthreads();
                {
                    int tq = threadIdx.x; asm volatile("" : "+v"(tq));
                    pg8::Unit u; const int i = tq >> 8, row = tq & 255;
                    if (g.unit(i, u)) {
                        const float* sp = (const float*)(ws + WS_O) + (size_t)(u.pm * 256 + row);
                        float rs[4];
#pragma unroll
                        for (int h = 0; h < 4; ++h) { float a[8];
#pragma unroll
                            for (int q = 0; q < 8; ++q) a[q] = sp[(size_t)(h * 8 + q) * T];
                            rs[h] = 1.0f / sqrtf(((a[0] + a[1]) + (a[2] + a[3]) + (a[4] + a[5]) + (a[6] + a[7])) * (1.0f / HV) + EPS); }
                        LAS float* tb = (LAS float*)(lds + L_IDX) + i * 1024 + row;
                        tb[0] = rs[0] / rs[1]; tb[256] = rs[1] / rs[2]; tb[512] = rs[2] / rs[3]; tb[768] = rs[3];
                    }
                }
                __syncthreads();
                pg8::gemm_phase(lds + L_STAGE, lds + L_IDX, g); SEAMT(7); if (DUP(7)) { pg8::gemm_phase(lds + L_STAGE, lds + L_IDX, g); SEAMT(7); } }
#else
#if G5_FP8
                pg8::ResidEpi<pg8::PlainGemmF8<0x7A7A7A7A>, false> g; g.A = (const bf16_t*)(ws + WS_A); g.Bt = (const bf16_t*)(ws + WS_WGO + (size_t)j2 * D * D); g.O = nullptr; g.N = D; g.K = D / 2; g.lda = D / 2; g.ldc = D; g.acol = 0; g.G = G; g.c = c;
#else
                pg8::ResidEpi<pg8::PlainGemm, false> g; g.A = (const bf16_t*)(ws + WS_A); g.Bt = (const bf16_t*)(ws + WS_WGO) + (size_t)j2 * D * D; g.O = nullptr; g.N = D; g.K = D; g.lda = D; g.ldc = D; g.acol = 0; g.G = G; g.c = c;
#endif
                g.Xin = (const bf16_t*)(ws + WS_X2); g.Xout = (bf16_t*)(ws + WS_X); g.g1 = (const float*)(ws + WS_MOD) + (size_t)layer * NB * 6144 + 2048; g.ps = nullptr; g.pb = nullptr;
                pg8::gemm_phase(lds + L_STAGE, lds + L_IDX, g); SEAMT(7); if (DUP(7)) { pg8::gemm_phase(lds + L_STAGE, lds + L_IDX, g); SEAMT(7); } }
#endif
        }
        if (EN(8) && RUN(base + 6)) { token_phase<2, false>(p, lds, layer); SEAMT(8); if (DUP(8)) { token_phase<2, false>(p, lds, layer, true); SEAMT(8); } }
        if (EN(9) && RUN(base + 7)) {
            moe_build_units(lds, (unsigned*)(ws + WS_CTL) + CW_CNT + layer * 64 * 16, G, c);
            pg8::Moe1 g; g.ut = (const LAS int*)(lds + L_UT); g.list = ws + WS_LIST; g.H = (const bf16_t*)(ws + (M1_FP8 ? WS_U : WS_H)); g.W = (const bf16_t*)(ws + WS_WMI + (size_t)layer * NE * 768 * D * (M1_FP8 ? 1 : 2)); g.ACT = (bf16_t*)(ws + WS_ACT); g.K = M1_FP8 ? D / 2 : D; g.lda = g.K;
            pg8::gemm_phase(lds + L_STAGE, lds + L_IDX, g); SEAMT(9); if (DUP(9)) { pg8::gemm_phase(lds + L_STAGE, lds + L_IDX, g); SEAMT(9); } }
        if (EN(10) && RUN(base + 8)) {
            pg8::Moe2 g; g.ut = (const LAS int*)(lds + L_UT2); g.list = ws + WS_LIST; g.ACT = (const bf16_t*)(ws + WS_ACT); g.W = (const bf16_t*)(ws + WS_WMO + (size_t)layer * NE * D * (M2_FP8 ? 512 : FF * 2)); g.Y = (bf16_t*)(ws + WS_Y); g.K = M2_FP8 ? 256 : FF; g.lda = g.K;
            pg8::gemm_phase(lds + L_STAGE, lds + L_IDX, g); SEAMT(10); if (DUP(10)) { pg8::gemm_phase(lds + L_STAGE, lds + L_IDX, g); SEAMT(10); } }
    }
    if (EN(11) && RUN(PH_FINAL)) { token_phase<3, false>(p, lds, 3); if (DUP(11)) { SEAMT(11); token_phase<3, false>(p, lds, 3, true); } }
#undef RUN
#undef SEAM
}

extern "C" void kernel_launch(void* const* d_in, const int* in_sizes, int n_in, void* d_out, int out_size, void* d_ws, size_t ws_size, hipStream_t stream) {
    static int grid = 0;
    if (grid == 0) {
        if (n_in != 20 || out_size != T * D || ws_size < WS_END2 + (DUPMASK ? (size_t)1040 * MiB : 0)) { fprintf(stderr, "kernel_launch: unexpected shapes (n_in %d out %d ws %zu)\n", n_in, out_size, ws_size); grid = -1; return; }
        int dev = 0, cus = 0, per_cu = 0;
        (void)hipGetDevice(&dev); (void)hipDeviceGetAttribute(&cus, hipDeviceAttributeMultiprocessorCount, dev);
        if (hipFuncSetAttribute((const void*)mk_fwd, hipFuncAttributeMaxDynamicSharedMemorySize, LDS_BYTES) != hipSuccess) { fprintf(stderr, "kernel_launch: hipFuncSetAttribute failed\n"); grid = -1; return; }
        (void)hipOccupancyMaxActiveBlocksPerMultiprocessor(&per_cu, (const void*)mk_fwd, NTHR, LDS_BYTES);
        (void)hipGetLastError();
        if (cus != 256 || per_cu < 1) fprintf(stderr, "kernel_launch: note: %d CUs, occupancy query %d (built for 256 CUs, one workgroup each)\n", cus, per_cu);
        grid = 256;
    }
    if (grid < 0) return;
    (void)hipMemsetAsync((char*)d_ws + WS_CTL, 0, CTL_ZERO_BYTES, stream);
    Params a{};
    for (int i = 0; i < 20; ++i) a.in[i] = (const float*)d_in[i];
    a.out = (float*)d_out; a.ws = (unsigned char*)d_ws; a.pad = 0;
#if MK_ONE_LAUNCH
    a.ph_lo = 0; a.ph_hi = PH_END; a.use_bar = 1;
    hipLaunchKernelGGL(mk_fwd, dim3(grid), dim3(NTHR), LDS_BYTES, stream, a);
#else
    a.use_bar = 0;
    for (int pid = 0; pid < PH_END; ++pid) {
        bool active = (pid == 0 || pid == PH_FINAL);
        if (pid >= 1 && pid < PH_FINAL) { const int L = (pid - 1) / 10, k = (pid - 1) % 10; const bool pool = (L & 1) == 0;
            active = (k == 0 || k == 6 || k == 7 || k == 8) || (pool ? (k == 1) : (k >= 1 && k <= 5)); }
        if (!active) continue;
        a.ph_lo = pid; a.ph_hi = pid + 1;
        hipLaunchKernelGGL(mk_fwd, dim3(grid), dim3(NTHR), LDS_BYTES, stream, a);
    }
#endif
}
```

```cpp
#include <hip/hip_runtime.h>
#include <cstdio>
#include <cstdint>

#ifndef M1_FP8
#define M1_FP8 1
#endif
#ifndef G2_VR8
#define G2_VR8 1
#endif
#ifndef G2_FP8
#define G2_FP8 0
#endif
#ifndef Y_FP8
#define Y_FP8 1
#endif
#ifndef G5_FP8
#define G5_FP8 1
#endif
#ifndef M2_FP8
#define M2_FP8 1
#endif
#ifndef FUSE_RES
#define FUSE_RES 1
#endif
#ifndef FUSE_G4
#define FUSE_G4 1
#endif
#ifndef XB_BF16
#define XB_BF16 1
#endif
#ifndef ROUTER_SPLIT
#define ROUTER_SPLIT 0
#endif
#ifndef MK_ONE_LAUNCH
#define MK_ONE_LAUNCH 1
#endif

#define LAS __attribute__((address_space(3)))
#define GAS __attribute__((address_space(1)))
typedef unsigned short bf16_t;
typedef short bf16x8 __attribute__((ext_vector_type(8)));
typedef float f32x4 __attribute__((ext_vector_type(4)));
typedef float f32x2 __attribute__((ext_vector_type(2)));
typedef unsigned u32x4 __attribute__((ext_vector_type(4)));
typedef unsigned u32x2 __attribute__((ext_vector_type(2)));

constexpr int NB = 8, SEQ = 4096, D = 1024, T = NB * SEQ, DEPTH = 4;
constexpr int GIN = 3088, NPROJ = 3072, GK = 512, HK = 128, HV = 256, NH = 4, CH = 64, NCH = SEQ / CH;
constexpr int NE = 64, FF = 384, NRT = 80;
constexpr float EPS = 1e-6f;
constexpr int NWAVES = 8, NTHR = 512;
constexpr int LISTCAP = 65536 + 256;

constexpr size_t MiB = 1u << 20;
constexpr size_t WS_CTL = 0, CTL_ZERO_BYTES = 65536;
constexpr size_t WS_MOD = 1 * MiB;
constexpr size_t WS_PAR = 1 * MiB + 786432;
constexpr int PAR_NG = 0, PAR_PB = 8192, PAR_PS = 10240, PAR_GWG = 12288, PAR_GBG = 28672, PAR_GNG = 29696, PAR_MBG = 30208, PAR_MBE = 30240, PAR_FNG = 30496, PAR_END = 31520;
constexpr size_t WS_WR = 2 * MiB;
constexpr size_t WS_WZ = 4 * MiB;
constexpr size_t WS_WPL = 5 * MiB;
constexpr size_t WS_WGO = 6 * MiB;
constexpr size_t WS_WGI = 10 * MiB;
constexpr size_t WS_WMO = 22 * MiB;
constexpr size_t WS_WMI = 214 * MiB;
constexpr size_t WS_X = 598 * MiB;
constexpr size_t WS_H = 726 * MiB;
constexpr size_t WS_U = 790 * MiB;
constexpr size_t WS_Y = 854 * MiB;
constexpr size_t WS_PROJ = 982 * MiB;
constexpr size_t WS_Z = 1174 * MiB;
constexpr size_t WS_FRAG = 1176 * MiB;
constexpr int FRAG_P = 0, FRAG_Q = 8192, FRAG_K = 24576, FRAG_D = 40960, FRAG_ITEM = 41472;
constexpr size_t WS_QE = 1176 * MiB;
constexpr size_t WS_KDT = 1208 * MiB;
constexpr size_t WS_PB = 1240 * MiB;
constexpr size_t WS_DEC = 1256 * MiB;
constexpr size_t WS_O = 1257 * MiB;
constexpr size_t WS_A = 1321 * MiB;
constexpr size_t WS_ACT = 1385 * MiB;
constexpr size_t WS_LIST = 1449 * MiB;
constexpr size_t WS_END = 1484 * MiB;
constexpr size_t WS_X2 = 1484 * MiB;
constexpr size_t WS_END2 = 1612 * MiB;
constexpr size_t WS_DRY = 1100 * MiB;
constexpr int CW_BAR = 4096;
constexpr int CW_CNT = 8192;
static_assert((CW_CNT + DEPTH * 64 * 16) * 4 <= (int)CTL_ZERO_BYTES, "control words inside the per-call memset");

constexpr int LDS_BYTES = 147456;
constexpr int L_STAGE = 0;
constexpr int L_IDX = 131072;
constexpr int L_UT = 131072 + 6144;
constexpr int L_ECNT = L_UT + 256;
constexpr int L_ETB = L_ECNT + 256;
constexpr int L_TT = L_ETB + 256;
constexpr int L_MISC = LDS_BYTES - 256;

typedef __bf16 bf16x2_t __attribute__((ext_vector_type(2)));
__device__ __forceinline__ unsigned pk2(float lo, float hi) { const bf16x2_t v = __builtin_convertvector((f32x2){lo, hi}, bf16x2_t); return __builtin_bit_cast(unsigned, v); }
__device__ __forceinline__ unsigned f2bf(float f) { return pk2(f, 0.f) & 0xffffu; }
__device__ __forceinline__ float bf2f(unsigned b) { return __builtin_bit_cast(float, b << 16); }
__device__ __forceinline__ float bflo(unsigned w) { return __builtin_bit_cast(float, w << 16); }
__device__ __forceinline__ float bfhi(unsigned w) { return __builtin_bit_cast(float, w & 0xffff0000u); }
template <int CTRL> __device__ __forceinline__ float dpp_f(float v) { return __builtin_bit_cast(float, __builtin_amdgcn_mov_dpp(__builtin_bit_cast(int, v), CTRL, 0xf, 0xf, true)); }
__device__ __forceinline__ float xsum16(float v) { const unsigned u = __builtin_bit_cast(unsigned, v); const auto r = __builtin_amdgcn_permlane16_swap(u, u, false, false); return __builtin_bit_cast(float, (unsigned)r[0]) + __builtin_bit_cast(float, (unsigned)r[1]); }
__device__ __forceinline__ float xsum32(float v) { const unsigned u = __builtin_bit_cast(unsigned, v); const auto r = __builtin_amdgcn_permlane32_swap(u, u, false, false); return __builtin_bit_cast(float, (unsigned)r[0]) + __builtin_bit_cast(float, (unsigned)r[1]); }
__device__ __forceinline__ float wave_sum(float v) {
    v += dpp_f<0xB1>(v); v += dpp_f<0x4E>(v); v += dpp_f<0x141>(v); v += dpp_f<0x140>(v);
    v = xsum16(v); return xsum32(v);
}
__device__ __forceinline__ unsigned cvt_pk_bf16(float lo, float hi) { unsigned r; asm volatile("v_cvt_pk_bf16_f32 %0, %1, %2" : "=v"(r) : "v"(lo), "v"(hi)); return r; }
#ifndef WT_STORES
#define WT_STORES 0
#endif
__device__ __forceinline__ void st16(void* p, u32x4 v) {
#if WT_STORES
    asm volatile("global_store_dwordx4 %0, %1, off sc1\n\ts_nop 1" :: "v"(p), "v"(v) : "memory");
#else
    *(u32x4*)p = v;
#endif
}
constexpr float YSC = 32.0f, YSCI = 1.0f / 32.0f, LOG2E = 1.4426950408889634f;
__device__ __forceinline__ f32x4 fp8x4(unsigned w) { const f32x2 lo = __builtin_amdgcn_cvt_pk_f32_fp8((int)w, false), hi = __builtin_amdgcn_cvt_pk_f32_fp8((int)w, true); return (f32x4){lo[0], lo[1], hi[0], hi[1]}; }
typedef int v8i __attribute__((ext_vector_type(8)));
typedef int v4i __attribute__((ext_vector_type(4)));
__device__ __forceinline__ unsigned pk4_fp8(float a, float b, float c, float d) {
    int w = 0; w = __builtin_amdgcn_cvt_pk_fp8_f32(a, b, w, false); w = __builtin_amdgcn_cvt_pk_fp8_f32(c, d, w, true); return (unsigned)w;
}
#define LDS_WAIT() asm volatile("s_waitcnt lgkmcnt(0)" ::: "memory")
#define VM_WAIT() asm volatile("s_waitcnt vmcnt(0)" ::: "memory")

#define XB_TMO      128
#define XB_XCNT(j)  (256  + 64 * (j))
#define XB_XSUB(j)  (1280 + 64 * (j))
#define XB_XGEN(j)  (2304 + 64 * (j))
#define XB_TOP      3328
#define XB_TOPGEN   3392
#define XCD_BAR_WORDS 3456
#define XB_SPIN_CAP (1u << 18)
__device__ __forceinline__ unsigned xb_ld(unsigned* p)              { return __hip_atomic_load(p, __ATOMIC_RELAXED, __HIP_MEMORY_SCOPE_AGENT); }
__device__ __forceinline__ unsigned xb_add(unsigned* p, unsigned v) { return __hip_atomic_fetch_add(p, v, __ATOMIC_RELAXED, __HIP_MEMORY_SCOPE_AGENT); }
__device__ __forceinline__ unsigned xb_xcc_id() { return (unsigned)__builtin_amdgcn_s_getreg((3 << 11) | 20) & 0xFu; }
#define XB_SPIN(cond, bar) do { unsigned _sp = 0; while (cond) { __builtin_amdgcn_s_sleep(1); \
    if ((++_sp & 255u) == 0u) { if (xb_ld(&(bar)[XB_TMO])) break; if (_sp > XB_SPIN_CAP) { atomicAdd(&(bar)[XB_TMO], 1u); break; } } } } while (0)
struct XcdBarrier { unsigned* bar; unsigned x; volatile LAS unsigned* st; };
__device__ __forceinline__ XcdBarrier xcd_barrier_post(unsigned* bar, volatile LAS unsigned* st) {
    XcdBarrier b; b.bar = bar; b.x = xb_xcc_id(); b.st = st;
    if (threadIdx.x == 0) (void)xb_add(&bar[XB_XCNT(b.x)], 1u);
    return b;
}
__device__ __forceinline__ void xcd_barrier_complete(unsigned* bar, unsigned x, unsigned& nloc, unsigned& nx) {
    const unsigned G = gridDim.x * gridDim.y * gridDim.z;
    unsigned sum, cnt, mine, sp = 0u;
    for (;;) {
        sum = 0u; cnt = 0u; mine = 0u;
#pragma unroll
        for (unsigned j = 0; j < 16; ++j) { const unsigned c = xb_ld(&bar[XB_XCNT(j)]); sum += c; cnt += (c > 0u) ? 1u : 0u; mine = (j == x) ? c : mine; }
        if (sum == G) break;
        __builtin_amdgcn_s_sleep(1);
        if ((++sp & 255u) == 0u) { if (xb_ld(&bar[XB_TMO])) break; if (sp > XB_SPIN_CAP) { atomicAdd(&bar[XB_TMO], 1u); break; } }
    }
    nloc = mine > 0u ? mine : 1u; nx = cnt > 0u ? cnt : 1u;
}
__device__ __forceinline__ void xcd_barrier(const XcdBarrier& b) {
    asm volatile("s_waitcnt vmcnt(0)" ::: "memory");
    __syncthreads();
    if (threadIdx.x == 0) {
        unsigned* bar = b.bar;
        __builtin_amdgcn_s_waitcnt(0);
        unsigned nloc = b.st[0], nx = b.st[1];
        if (nloc == 0u) { xcd_barrier_complete(bar, b.x, nloc, nx); b.st[0] = nloc; b.st[1] = nx; }
        const unsigned old = xb_add(&bar[XB_XSUB(b.x)], 1u);
        const unsigned gen = old / nloc;
        if (old + 1u == (gen + 1u) * nloc) {
            __builtin_amdgcn_fence(__ATOMIC_RELEASE, "agent");
            asm volatile("s_waitcnt vmcnt(0)" ::: "memory");
            const unsigned og = xb_add(&bar[XB_TOP], 1u);
            const unsigned tg = og / nx;
            if (og + 1u == (tg + 1u) * nx) xb_add(&bar[XB_TOPGEN], 1u);
            else XB_SPIN(xb_ld(&bar[XB_TOPGEN]) == tg, bar);
            __builtin_amdgcn_fence(__ATOMIC_ACQUIRE, "agent");
            asm volatile("s_waitcnt vmcnt(0)" ::: "memory");
        } else {
            XB_SPIN(xb_ld(&bar[XB_TOPGEN]) == gen, bar);
            __builtin_amdgcn_fence(__ATOMIC_ACQUIRE, "agent");
            asm volatile("s_waitcnt vmcnt(0)" ::: "memory");
        }
    }
    __syncthreads();
}

struct Params { const float* in[20]; float* out; unsigned char* ws; int ph_lo, ph_hi, use_bar, pad; };
enum { I_X = 0, I_C, I_NG, I_WMOD, I_BMOD, I_PW, I_PB, I_PS, I_GWIN, I_GWG, I_GBG, I_GNG, I_GWO, I_MWG, I_MBG, I_MWE, I_MBE, I_MWI, I_MWO, I_FNG };

namespace pg8 {
constexpr int BM = 256, BK = 64, HALF = 128, HTB = HALF * BK * 2, STAGE_BYTES = 8 * HTB, NXCD = 8, WGM = 8;
__host__ __device__ __forceinline__ int lds_byte(int r, int c) { const int st = (r >> 4) * 2 + (c >> 5), rr = r & 15, cc = c & 31, ob = rr * 64 + cc * 2; return st * 1024 + (ob ^ (((ob >> 9) & 1) << 5)); }
__host__ __device__ __forceinline__ void stage_rc(int b, int& R, int& C) { const int st = b / 1024, sb = b % 1024, swz = sb ^ (((sb >> 9) & 1) << 5); R = (st >> 1) * 16 + swz / 64; C = (st & 1) * 32 + (swz % 64) / 2; }
__host__ __device__ __forceinline__ int perm32(int rho) { const int n = rho >> 4, i = rho & 15; return 8 * (i >> 2) + 4 * n + (i & 3); }

struct Unit { int pm, pn, e, rows, slot0; };

template <class P>
__device__ __forceinline__ void gemm_phase(LAS unsigned char* lds, LAS unsigned char* idxb, const P& p) {
    int tid = threadIdx.x; asm volatile("" : "+v"(tid));
    const int wid = __builtin_amdgcn_readfirstlane(tid >> 6), lane = tid & 63, wr = wid >> 2, wc = wid & 3, fr = lane & 15, fq = lane >> 4;
    const int K = p.K, nt = K / BK, lda = p.lda;
    unsigned voffB[2];
#pragma unroll
    for (int i = 0; i < 2; ++i) { int R, C; stage_rc(tid * 16 + i * 8192, R, C);
        const int Rb = P::WIDE ? 64 * (R >> 5) + 16 * ((R & 15) >> 2) + 4 * ((R >> 4) & 1) + (R & 3) : P::LINE ? 64 * (R >> 5) + perm32(R & 31) : (R & ~31) + perm32(R & 31);
        voffB[i] = (unsigned)(Rb * K + C) * 2u; }
    unsigned vc[2][2];
    const size_t kstep = (size_t)(BK * 2);
    const size_t hstepB = (size_t)(P::WIDE ? 8 : P::LINE ? 32 : HALF) * K * 2;
    const unsigned ldsw = (unsigned)wid * 1024u;
    const int aoff = lds_byte(wr * 64 + fr, fq * 8), boff = lds_byte(wc * 32 + fr, fq * 8);
#define PG8_SA(b, h) (((b) * 2 + (h)) * HTB)
#define PG8_SB(b, h) ((4 + (b) * 2 + (h)) * HTB)
#define PG8_STAGE2(bufoff, gptr, v0, v1) do { \
        __builtin_amdgcn_global_load_lds((const unsigned*)((const char*)(gptr) + (v0)), (LAS unsigned*)(lds + (bufoff) + ldsw), 16, 0, 0); \
        __builtin_amdgcn_global_load_lds((const unsigned*)((const char*)(gptr) + (v1)), (LAS unsigned*)(lds + (bufoff) + ldsw + 8192), 16, 0, 0); } while (0)
#define PG8_STAGEB(bufoff, gptr) PG8_STAGE2(bufoff, gptr, voffB[0], voffB[1])
#define PG8_STAGEA(bufoff, gptr, V, h) PG8_STAGE2(bufoff, gptr, V[h][0], V[h][1])
#define PG8_LDA(dst, b, h) do { _Pragma("unroll") for (int m = 0; m < 4; ++m) _Pragma("unroll") for (int k = 0; k < 2; ++k) dst[m][k] = *(const LAS bf16x8*)(lds + PG8_SA(b, h) + aoff + m * 2048 + k * 1024); } while (0)
#define PG8_LDB(dst, b, h) do { _Pragma("unroll") for (int n = 0; n < 2; ++n) _Pragma("unroll") for (int k = 0; k < 2; ++k) dst[n][k] = *(const LAS bf16x8*)(lds + PG8_SB(b, h) + boff + n * 2048 + k * 1024); } while (0)
#define PG8_MMA(ai, bj, At, Bt) do { __builtin_amdgcn_s_setprio(1); _Pragma("unroll") for (int m = 0; m < 4; ++m) _Pragma("unroll") for (int n = 0; n < 2; ++n) _Pragma("unroll") for (int k = 0; k < 2; ++k) \
        acc[ai][bj][m][n] = __builtin_amdgcn_mfma_f32_16x16x32_bf16(Bt[n][k], At[m][k], acc[ai][bj][m][n], 0, 0, 0); __builtin_amdgcn_s_setprio(0); } while (0)
#define PG8_MMA8(ai, bj, At, Bt) do { __builtin_amdgcn_s_setprio(1); _Pragma("unroll") for (int m = 0; m < 4; ++m) _Pragma("unroll") for (int n = 0; n < 2; ++n) { \
        const v4i _b0 = __builtin_bit_cast(v4i, Bt[n][0]), _b1 = __builtin_bit_cast(v4i, Bt[n][1]), _a0 = __builtin_bit_cast(v4i, At[m][0]), _a1 = __builtin_bit_cast(v4i, At[m][1]); \
        acc[ai][bj][m][n] = __builtin_amdgcn_mfma_scale_f32_16x16x128_f8f6f4(__builtin_shufflevector(_b0, _b1, 0, 1, 2, 3, 4, 5, 6, 7), __builtin_shufflevector(_a0, _a1, 0, 1, 2, 3, 4, 5, 6, 7), \
                                                                                acc[ai][bj][m][n], 0, 0, 0, P::SCALE_B, 0, P::SCALE_A); } __builtin_amdgcn_s_setprio(0); } while (0)
#define PG8_MM(ai, bj, At, Bt) do { if constexpr (P::FP8) PG8_MMA8(ai, bj, At, Bt); else PG8_MMA(ai, bj, At, Bt); } while (0)
#define PG8_WAIT_V(n) asm volatile("s_waitcnt vmcnt(" #n ")" ::: "memory")
#define PG8_WAIT_L(n) asm volatile("s_waitcnt lgkmcnt(" #n ")" ::: "memory")
#define PG8_BAR __builtin_amdgcn_s_barrier()
#define PG8_SCHED __builtin_amdgcn_sched_barrier(0)
#define PG8_IDX_ISSUE(U, bufi) do { __builtin_amdgcn_global_load_lds((const unsigned*)(p.idx_src(U) + (size_t)(wid * 64 + lane) * 4), (LAS unsigned*)(idxb + (bufi) * 2048 + wid * 256), 4, 0, 0); } while (0)
#define PG8_AOFF(V, U, ibp) do { int _tt = tid; asm volatile("" : "+v"(_tt)); _Pragma("unroll") for (int i = 0; i < 2; ++i) { int _R, _C; stage_rc(_tt * 16 + i * 8192, _R, _C); _Pragma("unroll") for (int h = 0; h < 2; ++h) \
        V[h][i] = P::GATHER ? (p.a_rowoff(U, ibp, h * HALF + _R) + (unsigned)_C * 2u) : (unsigned)((h * HALF + _R) * lda + _C) * 2u; } } while (0)
    Unit cur, nxt; int ui = 0;
    if (!p.unit(0, cur)) return;
    int ib0 = 0, ib1 = 1, ib2 = 2;
    f32x4 acc[2][2][4][2];
#pragma unroll
    for (int a = 0; a < 2; ++a)
#pragma unroll
        for (int b = 0; b < 2; ++b)
#pragma unroll
            for (int m = 0; m < 4; ++m)
#pragma unroll
                for (int n = 0; n < 2; ++n) acc[a][b][m][n] = (f32x4){0.f, 0.f, 0.f, 0.f};
    bf16x8 At[4][2], B0[2][2], B1[2][2];
    const char* cA = p.a_base(cur); const char* cB = p.b_base(cur);
    if constexpr (P::GATHER) PG8_IDX_ISSUE(cur, 0);
    PG8_STAGEB(PG8_SB(0, 0), cB); PG8_STAGEB(PG8_SB(0, 1), cB + hstepB);
    if constexpr (P::GATHER && P::IDXA) { PG8_WAIT_V(4); PG8_BAR; }
    PG8_AOFF(vc, cur, (const LAS unsigned*)(idxb + ib0 * 2048));
    PG8_STAGEA(PG8_SA(0, 0), cA, vc, 0); PG8_STAGEA(PG8_SA(0, 1), cA, vc, 1);
    if (wr == 1) PG8_BAR;
    PG8_WAIT_V(2); PG8_BAR;
    PG8_STAGEB(PG8_SB(1, 0), cB + kstep); PG8_STAGEA(PG8_SA(1, 0), cA + kstep, vc, 0); PG8_STAGEB(PG8_SB(1, 1), cB + hstepB + kstep);
    PG8_WAIT_V(6); PG8_BAR;
    for (;;) {
        const bool has_next = p.unit(ui + 1, nxt);
        const char* nA = has_next ? p.a_base(nxt) : cA; const char* nB = has_next ? p.b_base(nxt) : cB;
        const bool full0 = !(P::GATHER || P::FP8) || cur.rows > 64 * wr, full = !(P::GATHER || P::FP8) || cur.rows > HALF + 64 * wr;
        if constexpr (P::GATHER) { if (has_next) PG8_IDX_ISSUE(nxt, ib1); }
        for (int t = 0; t < nt; t += 2) {
            const bool last = (t == nt - 2);
            const char* a1 = cA + (size_t)(t + 1) * kstep;
            const char* a2 = last ? nA : cA + (size_t)(t + 2) * kstep; const char* b2 = last ? nB : cB + (size_t)(t + 2) * kstep;
            const char* a3 = a2 + kstep; const char* b3 = b2 + kstep;
            if constexpr (P::HEADSCALE) { constexpr int TH = P::FP8 ? 2 : 4;
                if (t > 0 && t < 4 * TH && (t % TH) == 0) p.rescale(acc, ui, t / TH - 1, wr, fr); }
            PG8_LDB(B0, 0, 0); PG8_LDB(B1, 0, 1); PG8_SCHED; PG8_LDA(At, 0, 0);
            if (P::PADK && last) PG8_STAGE2(PG8_SA(1, 1), cA, 0u, 0u); else PG8_STAGEA(PG8_SA(1, 1), a1, vc, 1);
            PG8_WAIT_V(8); PG8_WAIT_L(0); PG8_BAR; if (full0) { PG8_MM(0, 0, At, B0); PG8_MM(0, 1, At, B1); } PG8_BAR; PG8_SCHED;
            if constexpr (P::GATHER) { if (last && has_next) { PG8_AOFF(vc, nxt, (const LAS unsigned*)(idxb + ib1 * 2048)); } }
            PG8_LDA(At, 0, 1); PG8_STAGEB(PG8_SB(0, 0), b2); PG8_STAGEB(PG8_SB(0, 1), b2 + hstepB); PG8_STAGEA(PG8_SA(0, 0), a2, vc, 0);
            PG8_WAIT_V(8); PG8_WAIT_L(0); PG8_BAR; if (full) { PG8_MM(1, 0, At, B0); PG8_MM(1, 1, At, B1); } PG8_BAR; PG8_SCHED;
            PG8_LDB(B0, 1, 0); PG8_LDB(B1, 1, 1); PG8_SCHED; PG8_LDA(At, 1, 0); PG8_STAGEA(PG8_SA(0, 1), a2, vc, 1);
            PG8_WAIT_V(8); PG8_WAIT_L(0); PG8_BAR; if (full0 && !(P::PADK && last)) { PG8_MM(0, 0, At, B0); PG8_MM(0, 1, At, B1); } PG8_BAR; PG8_SCHED;
            PG8_LDA(At, 1, 1);
            if (P::PADK && t == nt - 4) { PG8_STAGE2(PG8_SB(1, 0), cB, 0u, 0u); PG8_STAGE2(PG8_SB(1, 1), cB, 0u, 0u); PG8_STAGE2(PG8_SA(1, 0), cA, 0u, 0u); }
            else { PG8_STAGEB(PG8_SB(1, 0), b3); PG8_STAGEB(PG8_SB(1, 1), b3 + hstepB); PG8_STAGEA(PG8_SA(1, 0), a3, vc, 0); }
            PG8_WAIT_V(8); PG8_WAIT_L(0); PG8_BAR; if (full && !(P::PADK && last)) { PG8_MM(1, 0, At, B0); PG8_MM(1, 1, At, B1); } PG8_BAR; PG8_SCHED;
        }
        if (wr == 0) PG8_BAR;
        if constexpr (P::HEADSCALE) p.rescale(acc, ui, 3, wr, fr);
        p.epi(acc, cur, (const LAS unsigned*)(idxb + ib0 * 2048), wr, wc, fr, fq);
        if (!has_next) break;
#pragma unroll
        for (int a = 0; a < 2; ++a)
#pragma unroll
            for (int b = 0; b < 2; ++b)
#pragma unroll
                for (int m = 0; m < 4; ++m)
#pragma unroll
                    for (int n = 0; n < 2; ++n) acc[a][b][m][n] = (f32x4){0.f, 0.f, 0.f, 0.f};
        cur = nxt; cA = nA; cB = nB; ++ui;
        { const int t0 = ib0; ib0 = ib1; ib1 = ib2; ib2 = t0; }
        if (wr == 1) PG8_BAR;
    }
    PG8_WAIT_V(0);
    PG8_BAR;
#undef PG8_SA
#undef PG8_SB
#undef PG8_STAGE2
#undef PG8_STAGEB
#undef PG8_STAGEA
#undef PG8_LDA
#undef PG8_LDB
#undef PG8_MMA
#undef PG8_MMA8
#undef PG8_MM
#undef PG8_WAIT_V
#undef PG8_WAIT_L
#undef PG8_BAR
#undef PG8_SCHED
#undef PG8_IDX_ISSUE
#undef PG8_AOFF
}

struct PlainGemm {
    static constexpr bool GATHER = false, HEADSCALE = false, FP8 = false, PADK = false, WIDE = false, LINE = true, IDXA = false; static constexpr int SCALE_A = 0, SCALE_B = 0, CW = LINE ? 64 : 32, CB = LINE ? 32 : HALF;
    const bf16_t* A; const bf16_t* Bt; bf16_t* O; int N, K, lda, ldc, acol; int G, c;
    __device__ __forceinline__ bool unit(int i, Unit& u) const {
        const int nM = T / BM, nN = N / BM, nwg = nM * nN;
        const long L = (long)i * G + c; if (L >= nwg) return false;
        int wgid = (int)L; { const int q = nwg / NXCD, r = nwg % NXCD, xcd = wgid % NXCD, off = wgid / NXCD; wgid = (xcd < r ? xcd * (q + 1) : r * (q + 1) + (xcd - r) * q) + off; }
        const int nig = WGM * nN, gid = wgid / nig, fm = gid * WGM, gsz = (nM - fm) < WGM ? (nM - fm) : WGM;
        u.pm = fm + ((wgid % nig) % gsz); u.pn = (wgid % nig) / gsz; u.e = 0; { int rr = 256; asm volatile("" : "+s"(rr)); u.rows = rr; } u.slot0 = 0; return true;
    }
    __device__ __forceinline__ const char* a_base(const Unit& u) const { return (const char*)(A + (size_t)u.pm * BM * lda + (size_t)u.pn * acol); }
    __device__ __forceinline__ const char* b_base(const Unit& u) const { return (const char*)(Bt + (size_t)u.pn * BM * K); }
    __device__ __forceinline__ const char* idx_src(const Unit&) const { return nullptr; }
    __device__ __forceinline__ unsigned a_rowoff(const Unit&, const LAS unsigned*, int) const { return 0u; }
    __device__ __forceinline__ void epi(const f32x4 (&acc)[2][2][4][2], const Unit& u, const LAS unsigned*, int wr, int wc, int fr, int fq) const {
        const int row0 = u.pm * BM + wr * 64 + fr, col0 = u.pn * BM + wc * CW + 8 * fq;
#pragma unroll
        for (int ai = 0; ai < 2; ++ai)
#pragma unroll
            for (int m = 0; m < 4; ++m) { bf16_t* rowp = O + (size_t)(row0 + ai * HALF + m * 16) * ldc + col0;
#pragma unroll
                for (int bj = 0; bj < 2; ++bj) { const f32x4 v0 = acc[ai][bj][m][0], v1 = acc[ai][bj][m][1];
                    u32x4 w; w.x = cvt_pk_bf16(v0[0], v0[1]); w.y = cvt_pk_bf16(v0[2], v0[3]); w.z = cvt_pk_bf16(v1[0], v1[1]); w.w = cvt_pk_bf16(v1[2], v1[3]);
                    st16(rowp + bj * CB, w); } }
    }
};
template <int SB>
struct PlainGemmF8 : PlainGemm { static constexpr bool FP8 = true; static constexpr int SCALE_A = 0x7F7F7F7F, SCALE_B = SB; };
struct HeadScaleGemm : PlainGemm {
    static constexpr bool HEADSCALE = true;
    const LAS float* tab;
    __device__ __forceinline__ void rescale(f32x4 (&acc)[2][2][4][2], int ui, int h, int wr, int fr) const {
#pragma unroll
        for (int ai = 0; ai < 2; ++ai)
#pragma unroll
            for (int m = 0; m < 4; ++m) { const float f = tab[(ui * 4 + h) * 256 + (wr * 64 + fr) + (ai * HALF + m * 16)];
#pragma unroll
                for (int bj = 0; bj < 2; ++bj)
#pragma unroll
                    for (int n = 0; n < 2; ++n) acc[ai][bj][m][n] = acc[ai][bj][m][n] * f; }
    }
};
struct HeadScaleGemmF8 : HeadScaleGemm { static constexpr bool FP8 = true; static constexpr int SCALE_A = 0x7F7F7F7F, SCALE_B = 0x7A7A7A7A; };
template <class Base, bool POOL>
struct ResidEpi : Base {
    const bf16_t* Xin; bf16_t* Xout; const float* g1; const float* ps; const float* pb;
    __device__ __forceinline__ void epi(const f32x4 (&acc)[2][2][4][2], const Unit& u, const LAS unsigned*, int wr, int wc, int fr, int fq) const {
        constexpr int CW = Base::CW, CB = Base::CB;
        const int row0 = u.pm * BM + wr * 64 + fr, col0 = u.pn * BM + wc * CW + 8 * fq;
        const float* gp = g1 + (size_t)(u.pm >> 4) * 6144 + col0;
        f32x4 cC[2][2], cD[2][2];
#pragma unroll
        for (int bj = 0; bj < 2; ++bj)
#pragma unroll
            for (int n = 0; n < 2; ++n) {
                cC[bj][n] = *(const f32x4*)(gp + bj * CB + 4 * n);
                if (POOL) { const f32x4 s4 = *(const f32x4*)(ps + col0 + bj * CB + 4 * n), b4 = *(const f32x4*)(pb + col0 + bj * CB + 4 * n); cC[bj][n] = cC[bj][n] * s4; cD[bj][n] = cC[bj][n] * b4; }
            }
#pragma unroll
        for (int ai = 0; ai < 2; ++ai)
#pragma unroll
            for (int m = 0; m < 4; ++m) { const size_t ro = (size_t)(row0 + ai * HALF + m * 16) * this->ldc + col0;
#pragma unroll
                for (int bj = 0; bj < 2; ++bj) {
                    const u32x4 xi = *(const u32x4*)(Xin + ro + bj * CB);
                    const f32x4 x0 = (f32x4){bflo(xi.x), bfhi(xi.x), bflo(xi.y), bfhi(xi.y)}, x1 = (f32x4){bflo(xi.z), bfhi(xi.z), bflo(xi.w), bfhi(xi.w)};
                    f32x4 v0 = x0 + acc[ai][bj][m][0] * cC[bj][0], v1 = x1 + acc[ai][bj][m][1] * cC[bj][1];
                    if (POOL) { v0 = v0 + cD[bj][0]; v1 = v1 + cD[bj][1]; }
                    u32x4 w; w.x = cvt_pk_bf16(v0[0], v0[1]); w.y = cvt_pk_bf16(v0[2], v0[3]); w.z = cvt_pk_bf16(v1[0], v1[1]); w.w = cvt_pk_bf16(v1[2], v1[3]);
                    st16(Xout + ro + bj * CB, w); }
                asm volatile("" ::: "memory"); }
    }
};
struct MoeBase {
    static constexpr bool GATHER = true, HEADSCALE = false, FP8 = false, PADK = false, WIDE = false, LINE = false, IDXA = true; static constexpr int SCALE_A = 0, SCALE_B = 0;
    const LAS int* ut; const unsigned char* list;
    __device__ __forceinline__ bool unit(int i, Unit& u) const {
        if (i >= 8) return false;
        const LAS int* q = ut + i * 8; if (q[0] < 0) return false;
        u.e = q[0]; u.pm = q[1]; u.pn = q[2]; u.rows = q[3]; u.slot0 = q[4]; return true;
    }
    __device__ __forceinline__ const char* idx_src(const Unit& u) const { return (const char*)(list + ((size_t)u.e * LISTCAP + (size_t)u.pm * 256) * 8); }
};
struct Moe1 : MoeBase {
#if M1_FP8
    static constexpr bool FP8 = true; static constexpr int SCALE_A = 0x7F7F7F7F  , SCALE_B = 0x7A7A7A7A  ;
#endif
    const bf16_t* H; const bf16_t* W; bf16_t* ACT; int K, lda;
    __device__ __forceinline__ const char* a_base(const Unit&) const { return (const char*)H; }
    __device__ __forceinline__ const char* b_base(const Unit& u) const { return (const char*)W + ((size_t)u.e * 768 + (size_t)u.pn * 256) * (M1_FP8 ? 1024 : 2048); }
    __device__ __forceinline__ unsigned a_rowoff(const Unit& u, const LAS unsigned* ib, int r) const { const int rr = r < u.rows ? r : u.rows - 1; const unsigned id = ib[2 * rr]; return (id >> 1) * (M1_FP8 ? 1024u : 2048u); }
    __device__ __forceinline__ void epi(const f32x4 (&acc)[2][2][4][2], const Unit& u, const LAS unsigned*, int wr, int wc, int fr, int fq) const {
        const int row0 = u.slot0 + wr * 64 + fr, col0 = u.pn * 128 + wc * 32 + 8 * fq;
#pragma unroll
        for (int ai = 0; ai < 2; ++ai)
#pragma unroll
            for (int m = 0; m < 4; ++m) { bf16_t* rowp = ACT + (size_t)(row0 + ai * HALF + m * 16) * FF + col0;
                float v[8];
#pragma unroll
                for (int n = 0; n < 2; ++n)
#pragma unroll
                    for (int j = 0; j < 4; ++j) { const float g = acc[ai][0][m][n][j], up = acc[ai][1][m][n][j]; v[n * 4 + j] = M2_FP8 ? g * __builtin_amdgcn_rcpf(1.0f + __builtin_amdgcn_exp2f(-g)) * up : g * __builtin_amdgcn_rcpf(1.0f + __expf(-g)) * up; }
#if M2_FP8
                unsigned char* r8 = (unsigned char*)ACT + (size_t)(row0 + ai * HALF + m * 16) * 512 + col0;
                u32x2 w8; w8.x = pk4_fp8(v[0], v[1], v[2], v[3]); w8.y = pk4_fp8(v[4], v[5], v[6], v[7]);
                *(u32x2*)r8 = w8;
                (void)rowp;
#else
                u32x4 w; w.x = cvt_pk_bf16(v[0], v[1]); w.y = cvt_pk_bf16(v[2], v[3]); w.z = cvt_pk_bf16(v[4], v[5]); w.w = cvt_pk_bf16(v[6], v[7]);
                st16(rowp, w);
#endif
            }
    }
};
struct Moe2 : MoeBase {
#if M2_FP8
    static constexpr bool FP8 = true, PADK = true  , WIDE = Y_FP8 != 0, IDXA = false  ; static constexpr int SCALE_A = 0x7F7F7F7F, SCALE_B = 0x78787878  ;
#endif
    const bf16_t* ACT; const bf16_t* W; bf16_t* Y; int K, lda;
    __device__ __forceinline__ const char* a_base(const Unit&) const { return (const char*)ACT; }
    __device__ __forceinline__ const char* b_base(const Unit& u) const { return (const char*)W + ((size_t)u.e * 1024 + (size_t)u.pn * 256) * (M2_FP8 ? 512 : FF * 2); }
    __device__ __forceinline__ unsigned a_rowoff(const Unit& u, const LAS unsigned*, int r) const { return (unsigned)(u.slot0 + r) * (unsigned)(M2_FP8 ? 512 : FF * 2); }
    __device__ __forceinline__ void epi(const f32x4 (&acc)[2][2][4][2], const Unit& u, const LAS unsigned* ib, int wr, int wc, int fr, int fq) const {
        const int col0 = WIDE ? u.pn * 256 + wc * 64 + 16 * fq : u.pn * 256 + wc * 32 + 8 * fq;
#pragma unroll
        for (int ai = 0; ai < 2; ++ai)
#pragma unroll
            for (int m = 0; m < 4; ++m) { int r = ai * HALF + wr * 64 + m * 16 + fr; asm volatile("" : "+v"(r));
                if (r < u.rows) { const unsigned id = ib[2 * r]; const float wt = __builtin_bit_cast(float, ib[2 * r + 1]);
#if Y_FP8
                    unsigned char* rowp = (unsigned char*)Y + ((size_t)(id & 1u) * T + (size_t)(id >> 1)) * D + col0; const float ws_ = wt * YSC;
                    const f32x4 v0 = acc[ai][0][m][0] * ws_, v1 = acc[ai][0][m][1] * ws_, v2 = acc[ai][1][m][0] * ws_, v3 = acc[ai][1][m][1] * ws_;
                    u32x4 w; w.x = pk4_fp8(v0[0], v0[1], v0[2], v0[3]); w.y = pk4_fp8(v1[0], v1[1], v1[2], v1[3]); w.z = pk4_fp8(v2[0], v2[1], v2[2], v2[3]); w.w = pk4_fp8(v3[0], v3[1], v3[2], v3[3]);
                    *(u32x4*)rowp = w; }
#else
                    bf16_t* rowp = Y + ((size_t)(id & 1u) * T + (size_t)(id >> 1)) * D + col0;
#pragma unroll
                    for (int bj = 0; bj < 2; ++bj) { const f32x4 v0 = acc[ai][bj][m][0] * wt, v1 = acc[ai][bj][m][1] * wt;
                        u32x4 w; w.x = cvt_pk_bf16(v0[0], v0[1]); w.y = cvt_pk_bf16(v0[2], v0[3]); w.z = cvt_pk_bf16(v1[0], v1[1]); w.w = cvt_pk_bf16(v1[2], v1[3]);
                        st16(rowp + bj * HALF, w); } }
#endif
                asm volatile("" ::: "memory"); }
    }
};
}

constexpr int L_UT2 = L_TT + 16;
__device__ __forceinline__ void moe_build_units(LAS unsigned char* lds, unsigned* cntw, int G, int c) {
    int tid = threadIdx.x; asm volatile("" : "+v"(tid));
    const int lane = tid & 63;
    __syncthreads();
    if (tid < 64) {
        const int cnt = (int)__hip_atomic_load(cntw + lane * 16, __ATOMIC_RELAXED, __HIP_MEMORY_SCOPE_AGENT);
        const int tiles = (cnt + 255) >> 8;
        int incl = tiles;
#pragma unroll
        for (int o = 1; o < 64; o <<= 1) { const int v = __shfl_up(incl, o); if (lane >= o) incl += v; }
        const int etb = incl - tiles, TT = __shfl(incl, 63);
#pragma unroll
        for (int tb = 0; tb < 2; ++tb) {
            const int NT = 3 + tb, U = TT * NT; LAS int* ut = (LAS int*)(lds + (tb ? L_UT2 : L_UT));
#pragma unroll
            for (int u = 0; u < 8; ++u) {
                const int L = u * G + c;
                int wgid = L; { const int q = U / 8, r = U % 8, xcd = wgid % 8, off = wgid / 8; wgid = (xcd < r ? xcd * (q + 1) : r * (q + 1) + (xcd - r) * q) + off; }
                const int tau = wgid / NT, pn = wgid % NT;
                const bool hit = L < U && tau >= etb && tau < etb + tiles;
                if (__ballot(hit) == 0ull) { if (lane == 0) ut[u * 8] = -1; }
                else if (hit) { const int mt = tau - etb, rem = cnt - mt * 256; ut[u * 8 + 0] = lane; ut[u * 8 + 1] = mt; ut[u * 8 + 2] = pn; ut[u * 8 + 3] = rem > 256 ? 256 : rem; ut[u * 8 + 4] = tau * 256; }
            }
        }
    }
    __syncthreads();
}

constexpr int TK_AH = 0, TK_ROWB = 2064, TK_AL = 33024, TK_RED = 66048, TK_LOGIT = 107008, TK_COEF = 112128, TK_AE = 132608, TK_AW = 133632, TK_AR = 134656, TK_HIST = 135680, TK_BASE = 135936;
static_assert(TK_BASE + 256 <= L_MISC, "token-phase LDS map");
struct RowRaw { f32x4 x[4]; u32x2 xb[4]; u32x2 a[4]; u32x2 b[4]; };
__device__ __forceinline__ f32x4 bf4(u32x2 w) { return (f32x4){bflo(w.x), bfhi(w.x), bflo(w.y), bfhi(w.y)}; }

template <int MODE, bool FROM_IN>
__device__ __forceinline__ void tk_issue(RowRaw& R, const Params& p, int layer, int t, int lane) {
    unsigned char* ws = p.ws;
    constexpr bool from_in = FROM_IN;
    if (from_in || !XB_BF16) {
        const f32x4* xr = (const f32x4*)((from_in ? p.in[I_X] : (const float*)(ws + ((MODE == 2 && !FUSE_RES) ? WS_X2 : WS_X))) + (size_t)t * D) + lane;
#pragma unroll
        for (int j = 0; j < 4; ++j) R.x[j] = xr[64 * j];
    } else {
        const u32x2* xr = (const u32x2*)((const bf16_t*)(ws + ((MODE == 2 && !FUSE_RES) ? WS_X2 : WS_X)) + (size_t)t * D) + lane;
#pragma unroll
        for (int j = 0; j < 4; ++j) R.xb[j] = __builtin_nontemporal_load(xr + 64 * j);
    }
    if (MODE == 2 && FUSE_RES) {
    } else if (MODE == 2) {
        const u32x2* ur = (const u32x2*)((const bf16_t*)(ws + WS_U) + (size_t)t * D) + lane;
#pragma unroll
        for (int j = 0; j < 4; ++j) R.a[j] = __builtin_nontemporal_load(ur + 64 * j);
    } else if (!from_in) {
#if Y_FP8
        const unsigned* y0 = (const unsigned*)(ws + WS_Y + (size_t)t * D) + lane; const unsigned* y1 = (const unsigned*)(ws + WS_Y + (size_t)(T + t) * D) + lane;
#pragma unroll
        for (int j = 0; j < 4; ++j) { R.a[j].x = __builtin_nontemporal_load(y0 + 64 * j); R.b[j].x = __builtin_nontemporal_load(y1 + 64 * j); }
#else
        const u32x2* y0 = (const u32x2*)((const bf16_t*)(ws + WS_Y) + (size_t)t * D) + lane; const u32x2* y1 = (const u32x2*)((const bf16_t*)(ws + WS_Y) + (size_t)(T + t) * D) + lane;
#pragma unroll
        for (int j = 0; j < 4; ++j) { R.a[j] = __builtin_nontemporal_load(y0 + 64 * j); R.b[j] = __builtin_nontemporal_load(y1 + 64 * j); }
#endif
    }
}
template <int MODE, bool FROM_IN>
__device__ __forceinline__ void tk_row(const RowRaw& R, const Params& p, unsigned char* ws, LAS unsigned char* lds, int layer, int t, int rr, int lane, bool store) {
    constexpr bool from_in = FROM_IN;
    const LAS f32x4* cA4 = (const LAS f32x4*)(lds + TK_COEF); const LAS f32x4* cB4 = cA4 + 256; const LAS f32x4* cC4 = cA4 + 512; const LAS f32x4* cD4 = cA4 + 768; const LAS f32x4* cE4 = cA4 + 1024;
    f32x4 x[4];
#pragma unroll
    for (int j = 0; j < 4; ++j) {
        f32x4 xin = (XB_BF16 && MODE == 3) ? (f32x4){0.f, 0.f, 0.f, 0.f} : R.x[j];
        if (XB_BF16 && !from_in) xin = bf4(R.xb[j]);
        if (MODE == 2 && FUSE_RES) x[j] = xin;
        else if (MODE == 2) x[j] = xin + bf4(R.a[j]) * cC4[64 * j + lane] + cD4[64 * j + lane];
        else if (from_in) x[j] = xin;
        else if (Y_FP8) x[j] = xin + (fp8x4(R.a[j].x) + fp8x4(R.b[j].x)) * (cE4[64 * j + lane] * YSCI);
        else x[j] = xin + (bf4(R.a[j]) + bf4(R.b[j])) * cE4[64 * j + lane];
    }
    if (store && MODE != 3 && !(MODE == 2 && FUSE_RES)) {
        if (XB_BF16) {
            u32x2* xw = (u32x2*)((bf16_t*)(ws + (MODE == 2 ? WS_X : WS_X2)) + (size_t)t * D) + lane;
#pragma unroll
            for (int j = 0; j < 4; ++j) { u32x2 o; o.x = pk2(x[j][0], x[j][1]); o.y = pk2(x[j][2], x[j][3]); xw[64 * j] = o; }
        } else {
            f32x4* xw = (f32x4*)((float*)(ws + (MODE == 2 ? WS_X : WS_X2)) + (size_t)t * D) + lane;
#pragma unroll
            for (int j = 0; j < 4; ++j) xw[64 * j] = x[j];
        }
    }
    float ss = 0.f;
#pragma unroll
    for (int j = 0; j < 4; ++j) ss += (x[j][0] * x[j][0] + x[j][1] * x[j][1]) + (x[j][2] * x[j][2] + x[j][3] * x[j][3]);
    ss = wave_sum(ss);
    const float rstd = __builtin_amdgcn_rsqf(ss * (1.0f / D) + EPS);
#pragma unroll
    for (int j = 0; j < 4; ++j) {
        const f32x4 h = x[j] * rstd * cA4[64 * j + lane] + cB4[64 * j + lane];
        if (MODE == 3) { ((f32x4*)((ws == p.ws ? p.out : (float*)(ws + WS_X)) + (size_t)t * D))[64 * j + lane] = h; }
        else {
            u32x2 hi; hi.x = pk2(h[0], h[1]); hi.y = pk2(h[2], h[3]);
            if (MODE == 0) { *(LAS u32x2*)(lds + TK_AH + rr * TK_ROWB + (256 * j + 4 * lane) * 2) = hi; }
            else {
                if (MODE == 1 && G2_FP8) ((unsigned*)(ws + WS_H + (size_t)t * D))[64 * j + lane] = pk4_fp8(h[0], h[1], h[2], h[3]);
                else if (MODE == 2 && M1_FP8) ((unsigned*)(ws + WS_U + (size_t)t * D))[64 * j + lane] = pk4_fp8(h[0], h[1], h[2], h[3]);
                else ((u32x2*)((bf16_t*)(ws + WS_H) + (size_t)t * D))[64 * j + lane] = hi;
                if (MODE == 1 && G2_VR8) ((unsigned*)(ws + WS_U + 32 * MiB + (size_t)t * D))[64 * j + lane] = pk4_fp8(h[0], h[1], h[2], h[3]);
                const f32x4 r = h - bf4(hi);
                u32x2 lo; lo.x = pk2(r[0], r[1]); lo.y = pk2(r[2], r[3]);
                *(LAS u32x2*)(lds + TK_AH + rr * TK_ROWB + (256 * j + 4 * lane) * 2) = hi;
                *(LAS u32x2*)(lds + TK_AL + rr * TK_ROWB + (256 * j + 4 * lane) * 2) = lo;
            }
        }
    }
}
__device__ __forceinline__ void tk_pool_row(unsigned char* ws, LAS unsigned char* lds, int t, int ri, int lane) {
    const int pos = t & (SEQ - 1);
#pragma unroll
    for (int j = 0; j < 4; ++j) {
        const int win = 2 << j; const int cnt = (pos + 1) < win ? (pos + 1) : win;
        const LAS unsigned char* col = lds + TK_AH + (256 * j + 4 * lane) * 2;
        const f32x4 own = bf4(*(const LAS u32x2*)(col + ri * TK_ROWB));
        f32x4 s = own;
        for (int k = 1; k < cnt; ++k) s += bf4(*(const LAS u32x2*)(col + ((ri - k) & 31) * TK_ROWB));
        const f32x4 d = s * (1.0f / (float)cnt) - own;
        u32x2 o; o.x = pk2(d[0], d[1]); o.y = pk2(d[2], d[3]);
        ((u32x2*)((bf16_t*)(ws + WS_H) + (size_t)t * D))[64 * j + lane] = o;
    }
}
template <int MODE, bool FROM_IN>
__device__ __forceinline__ void tk_tile(const RowRaw (&R)[2], const Params& p, unsigned char* ws, LAS unsigned char* lds, int layer, int tok0, int tile, int tid, int lane, int w, const bf16x8 (&WRh)[4][(MODE == 2) ? 5 : 1], const bf16x8 (&WRl)[4][(MODE == 2) ? 5 : 1]) {
    constexpr bool HAS_MMA = (MODE == 1 || MODE == 2);
    constexpr int NCT = (MODE == 2) ? 5 : 1;
#pragma unroll
    for (int q = 0; q < 2; ++q) {
        const int rr = 2 * w + q;
        tk_row<MODE, FROM_IN>(R[q], p, ws, lds, layer, tok0 + tile * 16 + rr, MODE == 0 ? (16 * ((tile + 1) & 1) + rr) : rr, lane, true);
    }
    if (MODE == 0) {
        __syncthreads();
#pragma unroll 1
        for (int q = 0; q < 2; ++q) { const int rr = 2 * w + q; tk_pool_row(ws, lds, tok0 + tile * 16 + rr, 16 * ((tile + 1) & 1) + rr, lane); }
        __syncthreads();
    }
    if (HAS_MMA) {
        __syncthreads();
        f32x4 acc[NCT];
#pragma unroll
        for (int ct = 0; ct < NCT; ++ct) acc[ct] = (f32x4){0.f, 0.f, 0.f, 0.f};
#pragma unroll
        for (int ks = 0; ks < 4; ++ks) {
            const int kk = 128 * w + 32 * ks + 8 * (lane >> 4);
            const bf16x8 ah = *(const LAS bf16x8*)(lds + TK_AH + (lane & 15) * TK_ROWB + kk * 2);
            constexpr bool SPLIT = (MODE == 1) || ROUTER_SPLIT;
            bf16x8 al = ah;
            if (SPLIT) al = *(const LAS bf16x8*)(lds + TK_AL + (lane & 15) * TK_ROWB + kk * 2);
#pragma unroll
            for (int ct = 0; ct < NCT; ++ct) {
                acc[ct] = __builtin_amdgcn_mfma_f32_16x16x32_bf16(ah, WRh[ks][ct], acc[ct], 0, 0, 0);
                if (SPLIT) { acc[ct] = __builtin_amdgcn_mfma_f32_16x16x32_bf16(al, WRh[ks][ct], acc[ct], 0, 0, 0);
                             acc[ct] = __builtin_amdgcn_mfma_f32_16x16x32_bf16(ah, WRl[ks][ct], acc[ct], 0, 0, 0); }
            }
        }
        LAS float* red = (LAS float*)(lds + TK_RED);
#pragma unroll
        for (int ct = 0; ct < NCT; ++ct)
#pragma unroll
            for (int r = 0; r < 4; ++r) red[(w * 16 + 4 * (lane >> 4) + r) * NRT + 16 * ct + (lane & 15)] = acc[ct][r];
        __syncthreads();
        constexpr int NCOL = 16 * NCT;
        for (int idx = tid; idx < 16 * NCOL; idx += NTHR) {
            const int tk = idx / NCOL, n = idx % NCOL;
            float s = 0.f;
#pragma unroll
            for (int ww = 0; ww < 8; ++ww) s += red[(ww * 16 + tk) * NRT + n];
            if (MODE == 1) ((float*)(ws + WS_Z))[(size_t)(tok0 + tile * 16 + tk) * 16 + n] = s;
            else { const float* PAR = (const float*)(ws + WS_PAR); const float bias = n < 8 ? PAR[PAR_MBG + layer * 8 + n] : (n < 72 ? PAR[PAR_MBE + layer * 64 + n - 8] : 0.f); ((LAS float*)(lds + TK_LOGIT))[tk * NRT + n] = s + bias; }
        }
        if (MODE == 2) {
            __syncthreads();
            if (tid < 16) {
                const LAS float* lg = (const LAS float*)(lds + TK_LOGIT) + tid * NRT;
                int g = 0; float m = lg[0];
#pragma unroll
                for (int k = 1; k < 8; ++k) { const float v = lg[k]; if (v > m) { m = v; g = k; } }
                float sum = 0.f;
#pragma unroll
                for (int k = 0; k < 8; ++k) sum += __expf(lg[k] - m);
                const float pg = __builtin_amdgcn_rcpf(sum);
                const LAS float* le = lg + 8 + 8 * g;
                int e1 = 0; float l1 = le[0];
#pragma unroll
                for (int k = 1; k < 8; ++k) { const float v = le[k]; if (v > l1) { l1 = v; e1 = k; } }
                int e2 = -1; float l2 = -3.0e38f;
#pragma unroll
                for (int k = 0; k < 8; ++k) { const float v = le[k]; if (k != e1 && v > l2) { l2 = v; e2 = k; } }
                const float r = __expf(l2 - l1), inv = __builtin_amdgcn_rcpf(1.0f + r);
                const int a0 = (tile * 16 + tid) * 2;
                LAS int* ae = (LAS int*)(lds + TK_AE); LAS float* aw = (LAS float*)(lds + TK_AW); LAS int* ar = (LAS int*)(lds + TK_AR); LAS int* hist = (LAS int*)(lds + TK_HIST);
                const int f1 = g * 8 + e1, f2 = g * 8 + e2;
                ae[a0] = f1; aw[a0] = pg * inv; ar[a0] = atomicAdd((int*)&hist[f1], 1);
                ae[a0 + 1] = f2; aw[a0 + 1] = pg * r * inv; ar[a0 + 1] = atomicAdd((int*)&hist[f2], 1);
            }
        }
    }
}
template <int MODE, bool FROM_IN>
__device__ __forceinline__ void token_phase(const Params& p, LAS unsigned char* lds, int layer, bool dry = false) {
    int tid = threadIdx.x; asm volatile("" : "+v"(tid));
    const int lane = tid & 63, w = __builtin_amdgcn_readfirstlane(tid >> 6);
    const int c = blockIdx.x, tok0 = c * 128, b = tok0 / SEQ;
    unsigned char* ws = p.ws; unsigned char* wso = p.ws + (dry ? WS_DRY : 0);
    const float* MOD = (const float*)(ws + WS_MOD);
    LAS float* coef = (LAS float*)(lds + TK_COEF);
    const bool pool = (layer & 1) == 0; const int j2 = layer >> 1;
    RowRaw RA[2], RB[2];
#pragma unroll
    for (int q = 0; q < 2; ++q) tk_issue<MODE, FROM_IN>(RA[q], p, layer, tok0 + 2 * w + q, lane);
    for (int k = tid; k < D; k += NTHR) {
        float cA, cB = 0.f, cC = 0.f, cD = 0.f, cE = 0.f;
        const float* PAR = (const float*)(ws + WS_PAR);
        if (MODE == 3) { cA = PAR[PAR_FNG + k]; cE = MOD[((size_t)(3 * NB + b)) * 6144 + 5120 + k]; }
        else {
            const float* m = MOD + ((size_t)(layer * NB + b)) * 6144;
            if (MODE == 2) {
                cA = PAR[PAR_NG + (layer * 2 + 1) * D + k] * (1.0f + m[4096 + k]); cB = m[3072 + k];
                const float g1 = m[2048 + k];
                if (pool) { const float ps = PAR[PAR_PS + j2 * D + k], pb = PAR[PAR_PB + j2 * D + k]; cC = g1 * ps; cD = g1 * pb * ps; } else { cC = g1; cD = 0.f; }
            } else {
                cA = PAR[PAR_NG + (layer * 2 + 0) * D + k] * (1.0f + m[1024 + k]); cB = m[k];
                if (layer > 0) cE = MOD[((size_t)((layer - 1) * NB + b)) * 6144 + 5120 + k];
            }
        }
        coef[k] = cA; coef[1024 + k] = cB; coef[2048 + k] = cC; coef[3072 + k] = cD; coef[4096 + k] = cE;
    }
    if (MODE == 2 && tid < 64) ((LAS int*)(lds + TK_HIST))[tid] = 0;
    __syncthreads();
    const bf16_t* WH = nullptr; const bf16_t* WL = nullptr;
    if (MODE == 2) { WH = (const bf16_t*)(ws + WS_WR) + (size_t)(layer * 2 + 0) * NRT * D; WL = (const bf16_t*)(ws + WS_WR) + (size_t)(layer * 2 + 1) * NRT * D; }
    if (MODE == 1) { WH = (const bf16_t*)(ws + WS_WZ) + (size_t)(j2 * 2 + 0) * 16 * D; WL = (const bf16_t*)(ws + WS_WZ) + (size_t)(j2 * 2 + 1) * 16 * D; }
    constexpr int NCTW = (MODE == 2) ? 5 : 1;
    bf16x8 WRh[4][NCTW], WRl[4][NCTW];
    if (MODE == 1 || MODE == 2) {
#pragma unroll
        for (int ks = 0; ks < 4; ++ks)
#pragma unroll
            for (int ct = 0; ct < NCTW; ++ct) { const size_t fo = ((size_t)((w * 4 + ks) * NCTW + ct) * 64 + lane) * 8; WRh[ks][ct] = *(const bf16x8*)(WH + fo); if (MODE == 1 || ROUTER_SPLIT) WRl[ks][ct] = *(const bf16x8*)(WL + fo); else WRl[ks][ct] = WRh[ks][ct]; }
    }
    if (MODE == 0 && (tok0 & (SEQ - 1)) != 0) {
#pragma unroll 1
        for (int i = w + 1; i < 16; i += 8) { tk_issue<MODE, FROM_IN>(RB[0], p, layer, tok0 - 16 + i, lane); tk_row<MODE, FROM_IN>(RB[0], p, wso, lds, layer, tok0 - 16 + i, i, lane, false); }
    }
#pragma unroll 1
    for (int tile = 0; tile < 8; tile += 2) {
#pragma unroll
        for (int q = 0; q < 2; ++q) tk_issue<MODE, FROM_IN>(RB[q], p, layer, tok0 + (tile + 1) * 16 + 2 * w + q, lane);
        tk_tile<MODE, FROM_IN>(RA, p, wso, lds, layer, tok0, tile, tid, lane, w, WRh, WRl);
        if (tile + 2 < 8) {
#pragma unroll
            for (int q = 0; q < 2; ++q) tk_issue<MODE, FROM_IN>(RA[q], p, layer, tok0 + (tile + 2) * 16 + 2 * w + q, lane);
        }
        tk_tile<MODE, FROM_IN>(RB, p, wso, lds, layer, tok0, tile + 1, tid, lane, w, WRh, WRl);
    }
    if (MODE == 2) {
        unsigned* cntw = (unsigned*)(ws + WS_CTL) + CW_CNT + layer * 64 * 16;
        LAS int* hist = (LAS int*)(lds + TK_HIST); LAS int* base = (LAS int*)(lds + TK_BASE);
        __syncthreads();
        if (tid < 64) { const int h = hist[tid]; base[tid] = (h > 0 && !dry) ? (int)atomicAdd(cntw + tid * 16, (unsigned)h) : 0; }
        __syncthreads();
        if (tid < 256) {
            const int e = ((LAS int*)(lds + TK_AE))[tid]; const int pos = base[e] + ((LAS int*)(lds + TK_AR))[tid];
            u32x2 ent; ent.x = (unsigned)(tok0 * 2 + tid); ent.y = __builtin_bit_cast(unsigned, ((LAS float*)(lds + TK_AW))[tid]);
            *(u32x2*)(wso + WS_LIST + ((size_t)e * LISTCAP + (size_t)pos) * 8) = ent;
        }
    }
    __syncthreads();
}

__device__ __forceinline__ void gla_g4(const Params& p, int layer) {
    int tid = threadIdx.x; asm volatile("" : "+v"(tid));
    const int lane = tid & 63, w = tid >> 6; const int j2 = layer >> 1;
    unsigned char* ws = p.ws;
    const bf16_t* OB = (const bf16_t*)(ws + WS_O); const bf16_t* PR = (const bf16_t*)(ws + WS_PROJ); bf16_t* AB = (bf16_t*)(ws + WS_A);
    const f32x4 ng = ((const f32x4*)((const float*)(ws + WS_PAR) + PAR_GNG + j2 * HV))[lane];
    const int tok0 = blockIdx.x * 128 + w * 16;
    for (int i = 0; i < 16; ++i) {
        const int t = tok0 + i;
#pragma unroll
        for (int j = 0; j < 4; ++j) {
            const u32x2 ow = __builtin_nontemporal_load((const u32x2*)(OB + (size_t)t * D) + 64 * j + lane), rw = __builtin_nontemporal_load((const u32x2*)(PR + (size_t)t * NPROJ + 2048) + 64 * j + lane);
            const f32x4 o = (f32x4){bflo(ow.x), bfhi(ow.x), bflo(ow.y), bfhi(ow.y)}, r = (f32x4){bflo(rw.x), bfhi(rw.x), bflo(rw.y), bfhi(rw.y)};
            float ss = (o[0] * o[0] + o[1] * o[1]) + (o[2] * o[2] + o[3] * o[3]);
            ss = wave_sum(ss);
            const float rs = 1.0f / sqrtf(ss * (1.0f / HV) + EPS);
            f32x4 a;
#pragma unroll
            for (int e = 0; e < 4; ++e) a[e] = o[e] * rs * ng[e] * (r[e] / (1.0f + __expf(-r[e])));
            u32x2 out; out.x = pk2(a[0], a[1]); out.y = pk2(a[2], a[3]);
            if (G5_FP8) ((unsigned*)((unsigned char*)AB + (size_t)t * D))[64 * j + lane] = pk4_fp8(a[0], a[1], a[2], a[3]);
            else ((u32x2*)(AB + (size_t)t * D))[64 * j + lane] = out;
        }
    }
}

constexpr int GA_ZT = 0, GA_SEG = 4096, GA_QE = 6144, GA_KE = 23552, GA_Q = 40960, GA_K = 58368, GA_WG = 75776, GA_BG = 108544;
struct G3aRegs { u32x4 q[2], k[2]; f32x4 z; };
__device__ __forceinline__ void g3a_load(G3aRegs& R, const unsigned char* ws, int it, int tid) {
    const int hd = it & 3, n = (it >> 2) & 63, b = it >> 8, t0 = b * SEQ + n * CH;
    const bf16_t* PR = (const bf16_t*)(ws + WS_PROJ);
#pragma unroll
    for (int q = 0; q < 2; ++q) { const int pi = tid + 512 * q; const bf16_t* rp = PR + (size_t)(t0 + (pi >> 4)) * NPROJ + hd * HK + 8 * (pi & 15); R.q[q] = __builtin_nontemporal_load((const u32x4*)rp); R.k[q] = __builtin_nontemporal_load((const u32x4*)(rp + GK)); }
    R.z = tid < 256 ? ((const f32x4*)((const float*)(ws + WS_Z) + (size_t)t0 * 16))[tid] : (f32x4){0.f, 0.f, 0.f, 0.f};
}
__device__ __forceinline__ void gla_g3a(const Params& p, LAS unsigned char* lds, int layer) {
    int tid = threadIdx.x; asm volatile("" : "+v"(tid));
    const int lane = tid & 63, w = tid >> 6, d = tid & 127, seg = tid >> 7; const int j2 = layer >> 1;
    unsigned char* ws = p.ws;
    LAS float* ZT = (LAS float*)(lds + GA_ZT); LAS float* SEGT = (LAS float*)(lds + GA_SEG); LAS unsigned char* QEs = lds + GA_QE; LAS unsigned char* KEs = lds + GA_KE;
    G3aRegs R; g3a_load(R, ws, blockIdx.x * 8, tid);
    {
        float t[16];
#pragma unroll
        for (int i = 0; i < 16; ++i) t[i] = ((const float*)(ws + WS_PAR))[PAR_GWG + j2 * 16 * GK + tid + i * NTHR];
#pragma unroll
        for (int i = 0; i < 16; ++i) ((LAS float*)(lds + GA_WG))[tid + i * NTHR] = t[i] * LOG2E;
    }
    ((LAS float*)(lds + GA_BG))[tid] = ((const float*)(ws + WS_PAR))[PAR_GBG + j2 * GK + tid] * LOG2E;
#pragma unroll 1
    for (int ii = 0; ii < 8; ++ii) {
        const int it = blockIdx.x * 8 + ii, hd = it & 3;
#pragma unroll
        for (int q = 0; q < 2; ++q) { const int pi = tid + 512 * q; *(LAS u32x4*)(lds + GA_Q + (pi >> 4) * 272 + (pi & 15) * 16) = R.q[q]; *(LAS u32x4*)(lds + GA_K + (pi >> 4) * 272 + (pi & 15) * 16) = R.k[q]; }
        if (tid < 256) ((LAS f32x4*)ZT)[tid] = R.z;
        __syncthreads();
        if (ii + 1 < 8) g3a_load(R, ws, it + 1, tid);
        f32x2 wg[8];
#pragma unroll
        for (int j = 0; j < 8; ++j) wg[j] = (f32x2){((const LAS float*)(lds + GA_WG))[(2 * j) * GK + hd * HK + d], ((const LAS float*)(lds + GA_WG))[(2 * j + 1) * GK + hd * HK + d]};
        const float bg = ((const LAS float*)(lds + GA_BG))[hd * HK + d];
        float bc[16]; float run = 0.f;
#pragma unroll
        for (int r = 0; r < 16; ++r) {
            const LAS f32x4* zr = (const LAS f32x4*)(ZT + (16 * seg + r) * 16);
            f32x2 a2 = (f32x2){bg, 0.f};
#pragma unroll
            for (int q4 = 0; q4 < 4; ++q4) { const f32x4 z = zr[q4]; a2 = (f32x2){z[0], z[1]} * wg[2 * q4] + a2; a2 = (f32x2){z[2], z[3]} * wg[2 * q4 + 1] + a2; }
            const float pre = a2[0] + a2[1];
            const float ls = fminf(pre, 0.f) - __builtin_amdgcn_logf(1.0f + __builtin_amdgcn_exp2f(-fabsf(pre)));
            run += ls * (1.0f / 16.0f); bc[r] = run;
        }
        SEGT[seg * 128 + d] = run;
        __syncthreads();
        const float s0 = SEGT[d], s1 = SEGT[128 + d], s2 = SEGT[256 + d], s3 = SEGT[384 + d];
        const float prefix = (seg > 0 ? s0 : 0.f) + (seg > 1 ? s1 : 0.f) + (seg > 2 ? s2 : 0.f), total = (s0 + s1) + (s2 + s3);
        const float et = __builtin_amdgcn_exp2f(total);
        unsigned kdv[8];
#pragma unroll
        for (int r = 0; r < 16; ++r) {
            const int i = 16 * seg + r;
            const float q = bf2f(*(const LAS bf16_t*)(lds + GA_Q + i * 272 + d * 2)), k = bf2f(*(const LAS bf16_t*)(lds + GA_K + i * 272 + d * 2));
            const float bcum = bc[r] + prefix;
            const float qe = q * __builtin_amdgcn_exp2f(bcum) * 0.08838834764831845f, ke = k * __builtin_amdgcn_exp2f(-bcum), kd = ke * et;
            *(LAS bf16_t*)(QEs + i * 272 + d * 2) = (bf16_t)f2bf(qe);
            *(LAS bf16_t*)(KEs + i * 272 + d * 2) = (bf16_t)f2bf(ke);
            const unsigned kb = f2bf(kd);
            if (r & 1) kdv[r >> 1] |= kb << 16; else kdv[r >> 1] = kb;
        }
        {
            bf16_t* kf = (bf16_t*)(ws + WS_FRAG + (size_t)it * FRAG_ITEM + FRAG_K) + (size_t)(((d >> 4) * 2 + (seg >> 1)) * 64) * 8;
            *(u32x4*)(kf + (16 * ((2 * seg + 0) & 3) + (d & 15)) * 8) = (u32x4){kdv[0], kdv[1], kdv[2], kdv[3]};
            *(u32x4*)(kf + (16 * ((2 * seg + 1) & 3) + (d & 15)) * 8) = (u32x4){kdv[4], kdv[5], kdv[6], kdv[7]}; }
        if (seg == 0) ((float*)(ws + WS_FRAG + (size_t)it * FRAG_ITEM + FRAG_D))[d] = et;
        __syncthreads();
#pragma unroll
        for (int q = 0; q < 2; ++q) { const int pi = tid + 512 * q, fi = pi >> 8, ks = (pi >> 6) & 3, lf = pi & 63;
            *(u32x4*)((bf16_t*)(ws + WS_FRAG + (size_t)it * FRAG_ITEM + FRAG_Q) + (size_t)pi * 8) = *(const LAS u32x4*)(QEs + (16 * fi + (lf & 15)) * 272 + (32 * ks + 8 * (lf >> 4)) * 2); }
        const int it_ = w >> 1;
#pragma unroll
        for (int q = 0; q < 2; ++q) {
            const int jt = 2 * (w & 1) + q;
            f32x4 acc = (f32x4){0.f, 0.f, 0.f, 0.f};
            if (jt <= it_) {
#pragma unroll
                for (int ks = 0; ks < 4; ++ks) {
                    const int kk = 32 * ks + 8 * (lane >> 4);
                    const bf16x8 fk = *(const LAS bf16x8*)(KEs + (16 * jt + (lane & 15)) * 272 + kk * 2);
                    const bf16x8 fq = *(const LAS bf16x8*)(QEs + (16 * it_ + (lane & 15)) * 272 + kk * 2);
                    acc = __builtin_amdgcn_mfma_f32_16x16x32_bf16(fk, fq, acc, 0, 0, 0);
                }
            }
            const int i = 16 * it_ + (lane & 15), jb = 16 * jt + 4 * (lane >> 4);
            float v[4];
#pragma unroll
            for (int r = 0; r < 4; ++r) v[r] = (jb + r <= i) ? acc[r] : 0.f;
            u32x2 o; o.x = pk2(v[0], v[1]); o.y = pk2(v[2], v[3]);
            *(u32x2*)((bf16_t*)(ws + WS_FRAG + (size_t)it * FRAG_ITEM + FRAG_P) + (size_t)(((it_ * 2 + (jt >> 1)) * 64 + 16 * ((2 * jt + (lane >> 5)) & 3) + (lane & 15)) * 8 + 4 * ((lane >> 4) & 1))) = o;
        }
        __syncthreads();
    }
}

constexpr int G3_VT = 0, G3_ST = 4608, G3_RT = 13312, G3_SET = 17408;
struct G3Regs { u32x4 f[6]; u32x4 vr; };
__device__ __forceinline__ void g3_load(G3Regs& R, const unsigned char* ws, unsigned of, unsigned orr, unsigned ovv, int b, int hd, int n, int w) {
    const int item = (b * NCH + n) * NH + hd, t0 = b * SEQ + n * CH;
    const unsigned char* fb = ws + WS_FRAG + (size_t)item * FRAG_ITEM;
    const unsigned char* pr = ws + WS_PROJ + (size_t)t0 * NPROJ * 2;
    if (w < 4) {
        const u32x4* pf = (const u32x4*)(fb + FRAG_P + w * 2048 + of);
        const u32x4* qf = (const u32x4*)(fb + FRAG_Q + w * 4096 + of);
        R.f[0] = pf[0]; R.f[1] = pf[64]; R.f[2] = qf[0]; R.f[3] = qf[64]; R.f[4] = qf[128]; R.f[5] = qf[192];
    } else {
        const u32x4* kf = (const u32x4*)(fb + FRAG_K + (w - 4) * 4096 + of);
        const u32x4* dc = (const u32x4*)(fb + FRAG_D + (w - 4) * 128 + orr);
        R.f[0] = kf[0]; R.f[1] = kf[64]; R.f[2] = kf[128]; R.f[3] = kf[192]; R.f[4] = dc[0]; R.f[5] = dc[4];
    }
    R.vr = *(const u32x4*)(pr + ovv);
}
__device__ __forceinline__ bf16x8 asbf(u32x4 v) { return __builtin_bit_cast(bf16x8, v); }
typedef short s16x4 __attribute__((ext_vector_type(4)));
__device__ __forceinline__ bf16x8 g3_vfrag(LAS unsigned char* p) {
    const s16x4 a = __builtin_amdgcn_ds_read_tr16_b64_v4i16((LAS s16x4*)p), b = __builtin_amdgcn_ds_read_tr16_b64_v4i16((LAS s16x4*)(p + 256));
    return __builtin_shufflevector(a, b, 0, 1, 2, 3, 4, 5, 6, 7);
}
__device__ __forceinline__ void g3_step(G3Regs& R, unsigned of, unsigned orr, unsigned ovv, unsigned bvt, LAS unsigned char* sb, f32x4 (&S)[2][2], LAS const unsigned char* ngl, unsigned char* ws, int b, int hd, int vs, int n, int tid, int lane, int w) {
    if ((tid & 7) < 4) *(LAS u32x4*)(sb + G3_VT + (tid >> 3) * 64 + (((2 * (tid & 7)) ^ (4 * (w & 1))) * 8)) = R.vr;
    else *(LAS u32x4*)(sb + G3_RT + (tid >> 3) * 64 + ((tid & 7) - 4) * 16) = R.vr;
    if (w >= 4) {
#pragma unroll
        for (int dtl = 0; dtl < 2; ++dtl)
#pragma unroll
            for (int vt = 0; vt < 2; ++vt) { u32x2 a; a.x = pk2(S[dtl][vt][0], S[dtl][vt][1]); a.y = pk2(S[dtl][vt][2], S[dtl][vt][3]);
                *(LAS u32x2*)(sb + G3_ST + (16 * vt + (lane & 15)) * 272 + (16 * (2 * (w - 4) + dtl) + 4 * (lane >> 4)) * 2) = a; }
    }
    __syncthreads();
    const G3Regs& C = R;
    const int t0 = b * SEQ + n * CH;
    if (w < 4) {
        float ssq = 0.f; unsigned pk0 = 0u;
        const u32x4 rx = *(const LAS u32x4*)(sb + G3_RT + (16 * w + (lane & 15)) * 64 + (lane >> 4) * 16);
        bf16x8 fvv[2][2], fss[2][4];
#pragma unroll
        for (int vt = 0; vt < 2; ++vt) {
#pragma unroll
            for (int ks = 0; ks < 2; ++ks) fvv[vt][ks] = g3_vfrag(sb + G3_VT + (bvt ^ (unsigned)(8 * vt)) + 2048 * ks);
#pragma unroll
            for (int ks = 0; ks < 4; ++ks) fss[vt][ks] = *(const LAS bf16x8*)(sb + G3_ST + (16 * vt + (lane & 15)) * 272 + (32 * ks + 8 * (lane >> 4)) * 2);
        }
        f32x4 aP[2], aQ[2], aR[2];
#pragma unroll
        for (int vt = 0; vt < 2; ++vt) { aP[vt] = __builtin_amdgcn_mfma_f32_16x16x32_bf16(fvv[vt][0], asbf(C.f[0]), (f32x4){0.f, 0.f, 0.f, 0.f}, 0, 0, 0);
            aQ[vt] = __builtin_amdgcn_mfma_f32_16x16x32_bf16(fss[vt][0], asbf(C.f[2]), (f32x4){0.f, 0.f, 0.f, 0.f}, 0, 0, 0);
            aR[vt] = __builtin_amdgcn_mfma_f32_16x16x32_bf16(fss[vt][2], asbf(C.f[4]), (f32x4){0.f, 0.f, 0.f, 0.f}, 0, 0, 0); }
#pragma unroll
        for (int vt = 0; vt < 2; ++vt) { aP[vt] = __builtin_amdgcn_mfma_f32_16x16x32_bf16(fvv[vt][1], asbf(C.f[1]), aP[vt], 0, 0, 0);
            aQ[vt] = __builtin_amdgcn_mfma_f32_16x16x32_bf16(fss[vt][1], asbf(C.f[3]), aQ[vt], 0, 0, 0);
            aR[vt] = __builtin_amdgcn_mfma_f32_16x16x32_bf16(fss[vt][3], asbf(C.f[5]), aR[vt], 0, 0, 0); }
#pragma unroll
        for (int vt = 0; vt < 2; ++vt) {
            f32x4 acc = (aP[vt] + aQ[vt]) + aR[vt];
            if (FUSE_G4) {
                ssq += (acc[0] * acc[0] + acc[1] * acc[1]) + (acc[2] * acc[2] + acc[3] * acc[3]);
                u32x2 rw; rw.x = vt ? rx.z : rx.x; rw.y = vt ? rx.w : rx.y;
                const f32x4 rv = bf4(rw);
                const f32x4 ngv = *(const LAS f32x4*)(ngl + (8 * (lane >> 4) + 4 * vt) * 4);
#pragma unroll
                for (int r = 0; r < 4; ++r) acc[r] = acc[r] * ngv[r] * (rv[r] * __builtin_amdgcn_rcpf(1.0f + __expf(-rv[r])));
                if (G5_FP8) { const unsigned pk = pk4_fp8(acc[0], acc[1], acc[2], acc[3]); if (vt == 0) pk0 = pk; else *(u32x2*)(ws + WS_A + (size_t)(t0 + 16 * w + (lane & 15)) * D + hd * HV + vs * 32 + 8 * (lane >> 4)) = (u32x2){pk0, pk}; }
                else { u32x2 o; o.x = pk2(acc[0], acc[1]); o.y = pk2(acc[2], acc[3]);
                    *(u32x2*)((bf16_t*)(ws + WS_A) + (size_t)(t0 + 16 * w + (lane & 15)) * D + hd * HV + vs * 32 + 16 * vt + 4 * (lane >> 4)) = o; }
            } else {
                u32x2 o; o.x = pk2(acc[0], acc[1]); o.y = pk2(acc[2], acc[3]);
                *(u32x2*)((bf16_t*)(ws + WS_O) + (size_t)(t0 + 16 * w + (lane & 15)) * D + hd * HV + vs * 32 + 16 * vt + 4 * (lane >> 4)) = o;
            }
        }
        if (FUSE_G4) { ssq = xsum32(ssq); ssq = xsum16(ssq);
            if (lane < 16) ((float*)(ws + WS_O))[(size_t)(hd * 8 + vs) * T + t0 + 16 * w + lane] = ssq; }
    } else {
#pragma unroll
        for (int dtl = 0; dtl < 2; ++dtl) {
            const f32x4 dec = __builtin_bit_cast(f32x4, C.f[4 + dtl]);
#pragma unroll
            for (int vt = 0; vt < 2; ++vt) {
                f32x4 u = (f32x4){0.f, 0.f, 0.f, 0.f};
#pragma unroll
                for (int ks = 0; ks < 2; ++ks) { const bf16x8 fb = g3_vfrag(sb + G3_VT + (bvt ^ (unsigned)(8 * vt)) + 2048 * ks);
                    u = __builtin_amdgcn_mfma_f32_16x16x32_bf16(asbf(C.f[dtl * 2 + ks]), fb, u, 0, 0, 0); }
                S[dtl][vt] = dec * S[dtl][vt] + u;
            }
        }
    }
    g3_load(R, ws, of, orr, ovv, b, hd, n + 4 < NCH ? n + 4 : NCH - 1, w);
}
__device__ __forceinline__ void gla_g3b(const Params& p, LAS unsigned char* lds, int layer) {
    int tid = threadIdx.x; asm volatile("" : "+v"(tid));
    const int lane = tid & 63, w = __builtin_amdgcn_readfirstlane(tid >> 6);
    const int c = blockIdx.x, gi = c & 31, vs = c >> 5, b = gi >> 2, hd = gi & 3;
    unsigned char* ws = p.ws;
    f32x4 S[2][2];
#pragma unroll
    for (int i = 0; i < 2; ++i)
#pragma unroll
        for (int j = 0; j < 2; ++j) S[i][j] = (f32x4){0.f, 0.f, 0.f, 0.f};
    const bool leader = (vs == 0);
    LAS unsigned char* ngl = lds + 2 * G3_SET;
    if (tid < 32) ((LAS float*)ngl)[tid] = ((const float*)(ws + WS_PAR))[PAR_GNG + (layer >> 1) * HV + vs * 32 + tid];
    G3Regs RA, RB, RC, RD;
    const unsigned of = (unsigned)lane * 16u, orr = w < 4 ? (unsigned)(((16 * w + (lane & 15)) * NPROJ + 2048 + hd * HV + vs * 32 + 8 * (lane >> 4)) * 2) : (unsigned)(16 * (lane >> 4)),
                   ovv = (unsigned)(((tid >> 3) * NPROJ + 1024 + (hd * 8 + vs) * 64 + (tid & 7) * 8) * 2);
    const unsigned bvt = (unsigned)((8 * (lane >> 4) + ((lane & 15) >> 2)) * 64 + (((2 * (lane & 3)) ^ (4 * ((lane >> 4) & 1))) * 8));
    g3_load(RA, ws, of, orr, ovv, b, hd, 0, w); g3_load(RB, ws, of, orr, ovv, b, hd, 1, w); g3_load(RC, ws, of, orr, ovv, b, hd, 2, w);
    g3_load(RD, ws, of, orr, ovv, b, hd, 3, w);
#pragma unroll 1
    for (int n = 0; n < NCH; n += 4) {
        g3_step(RA, of, orr, ovv, bvt, lds, S, ngl, ws, b, hd, vs, n, tid, lane, w);
        g3_step(RB, of, orr, ovv, bvt, lds + G3_SET, S, ngl, ws, b, hd, vs, n + 1, tid, lane, w);
        g3_step(RC, of, orr, ovv, bvt, lds, S, ngl, ws, b, hd, vs, n + 2, tid, lane, w);
        g3_step(RD, of, orr, ovv, bvt, lds + G3_SET, S, ngl, ws, b, hd, vs, n + 3, tid, lane, w);
    }
    __syncthreads();
}

struct P0Item { const float* W; bf16_t* WT; int Nstride, drow, Kdst, k0, n0, fp8; };
__device__ __forceinline__ bool p0_item(const Params& p, int it, P0Item& o) {
    constexpr int I_A = M1_FP8 ? 0 : 256 * 384, I_B = M2_FP8 ? 0 : 256 * 192, I_C2 = 2 * 1536, I_D = G5_FP8 ? 0 : 2 * 512, I_E = 8 * 32;
    unsigned char* ws = p.ws; int r = it; if (r < 0) return false;
    if (r < I_A) { const int mat = r / 384, q = r % 384, kb = q / 24, nb = q % 24, n0 = nb * 32;
        o.W = p.in[I_MWI] + (size_t)mat * D * 768; o.WT = (bf16_t*)(ws + WS_WMI + (size_t)mat * 768 * D * (M1_FP8 ? 1 : 2)); o.Nstride = 768; o.Kdst = D; o.k0 = kb * 64; o.n0 = n0; o.fp8 = M1_FP8;
        o.drow = n0 < FF ? (256 * (n0 / 128) + (n0 % 128)) : (256 * ((n0 - FF) / 128) + 128 + ((n0 - FF) % 128)); return true; }
    r -= I_A;
    if (r < I_B) { const int mat = r / 192, q = r % 192, kb = q / 32, nb = q % 32;
        o.fp8 = M2_FP8 ? 2 : 0; o.W = p.in[I_MWO] + (size_t)mat * FF * D; o.WT = (bf16_t*)(ws + WS_WMO + (size_t)mat * D * (M2_FP8 ? 512 : FF * 2)); o.Nstride = D; o.Kdst = M2_FP8 ? 512 : FF; o.k0 = kb * 64; o.n0 = nb * 32; o.drow = nb * 32; return true; }
    r -= I_B;
    if (r < I_C2) { const int mat = r / 1536, q = r % 1536, kb = q / 96, nb = q % 96;
        o.fp8 = G2_FP8 ? 1 : 0; o.W = p.in[I_GWIN] + (size_t)mat * D * GIN; o.WT = (bf16_t*)(ws + WS_WGI + (size_t)mat * NPROJ * D * (G2_FP8 ? 1 : 2)); o.Nstride = GIN; o.Kdst = D; o.k0 = kb * 64; o.n0 = nb * 32; o.drow = nb < 32 ? nb * 32 : 1024 + (nb < 64 ? (nb - 32) * 64 : (nb - 64) * 64 + 32);
        if (G2_VR8) { const bool vr = nb >= 32;
            o.fp8 = vr ? 1 : 0; o.WT = (bf16_t*)(ws + WS_WGI + (vr ? 4 * MiB : 0) + (size_t)mat * 2 * MiB); o.drow = vr ? (nb < 64 ? (nb - 32) * 64 : (nb - 64) * 64 + 32) : nb * 32; }
        return true; }
    r -= I_C2;
    if (r < I_D) { const int mat = r / 512, q = r % 512, kb = q / 32, nb = q % 32;
        o.fp8 = G5_FP8 ? 1 : 0; o.W = p.in[I_GWO] + (size_t)mat * D * D; o.WT = (bf16_t*)(ws + WS_WGO + (size_t)mat * D * D * (G5_FP8 ? 1 : 2)); o.Nstride = D; o.Kdst = D; o.k0 = kb * 64; o.n0 = nb * 32; o.drow = nb * 32; return true; }
    r -= I_D;
    if (r < I_E) { const int mat = r / 32, q = r % 32, kb = q / 8, nb = q % 8;
        o.fp8 = 0; o.W = p.in[I_PW] + (size_t)mat * 256 * 256; o.WT = (bf16_t*)(ws + WS_WPL) + (size_t)mat * 256 * 256; o.Nstride = 256; o.Kdst = 256; o.k0 = kb * 64; o.n0 = nb * 32; o.drow = nb * 32; return true; }
    return false;
}
__device__ __forceinline__ void p0_load(const P0Item& o, float (&v)[32], int lane) {
#pragma unroll
    for (int i = 0; i < 8; ++i) { const f32x4 t = __builtin_nontemporal_load((const f32x4*)(o.W + (size_t)(o.k0 + 8 * i + (lane >> 3)) * o.Nstride + o.n0 + 4 * (lane & 7))); v[4 * i] = t[0]; v[4 * i + 1] = t[1]; v[4 * i + 2] = t[2]; v[4 * i + 3] = t[3]; }
}
__device__ __forceinline__ void p0_emit(const P0Item& o, const float (&v)[32], LAS float* scr, int lane) {
#pragma unroll
    for (int i = 0; i < 8; ++i)
#pragma unroll
        for (int e = 0; e < 4; ++e) scr[(8 * i + (lane >> 3)) * 33 + 4 * (lane & 7) + e] = v[4 * i + e];
    LDS_WAIT(); asm volatile("" ::: "memory");
    const int c = lane & 7;
#pragma unroll
    for (int j = 0; j < 4; ++j) { const int n = (lane >> 3) + 8 * j; const LAS float* s = scr + (8 * c) * 33 + n;
        if (o.fp8) { const float sc = o.fp8 == 1 ? 32.f : 16.f;
            u32x2 w8; w8.x = pk4_fp8(s[0 * 33] * sc, s[1 * 33] * sc, s[2 * 33] * sc, s[3 * 33] * sc); w8.y = pk4_fp8(s[4 * 33] * sc, s[5 * 33] * sc, s[6 * 33] * sc, s[7 * 33] * sc);
            unsigned char* dp = (unsigned char*)o.WT + (size_t)(o.drow + n) * o.Kdst;
            *(u32x2*)(dp + o.k0 + 8 * c) = w8;
            if (o.fp8 == 2 && o.k0 == 320) { *(u32x2*)(dp + 384 + 8 * c) = (u32x2){0u, 0u}; *(u32x2*)(dp + 448 + 8 * c) = (u32x2){0u, 0u}; } }
        else { u32x4 w; w.x = pk2(s[0 * 33], s[1 * 33]); w.y = pk2(s[2 * 33], s[3 * 33]); w.z = pk2(s[4 * 33], s[5 * 33]); w.w = pk2(s[6 * 33], s[7 * 33]);
            *(u32x4*)(o.WT + (size_t)(o.drow + n) * o.Kdst + o.k0 + 8 * c) = w; } }
    LDS_WAIT(); asm volatile("" ::: "memory");
}
struct P8Item { const float* W; unsigned char* WT; int Nstride, drow, Kdst, k0, n0, kind; };
constexpr int P8_A = M1_FP8 ? 256 * 8 * 24 : 0, P8_B = M2_FP8 ? 256 * 3 * 32 : 0, P8_D = G5_FP8 ? 2 * 8 * 32 : 0;
template <int WHICH>
__device__ __forceinline__ bool p8_item(const Params& p, int r, P8Item& o) {
    unsigned char* ws = p.ws;
    if (WHICH == 0) { if (r >= P8_A) return false; const int mat = r / 192, q = r % 192, kb = q / 24, nb = q % 24, n0 = nb * 32;
        o.W = p.in[I_MWI] + (size_t)mat * D * 768; o.WT = ws + WS_WMI + (size_t)mat * 768 * D; o.Nstride = 768; o.Kdst = D; o.k0 = kb * 128; o.n0 = n0; o.kind = 3;
        o.drow = n0 < FF ? (256 * (n0 / 128) + (n0 % 128)) : (256 * ((n0 - FF) / 128) + 128 + ((n0 - FF) % 128)); return true; }
    if (WHICH == 1) { if (r >= P8_B) return false; const int mat = r / 96, q = r % 96, kb = q / 32, nb = q % 32;
        o.W = p.in[I_MWO] + (size_t)mat * FF * D; o.WT = ws + WS_WMO + (size_t)mat * D * 512; o.Nstride = D; o.Kdst = 512; o.k0 = kb * 128; o.n0 = nb * 32; o.drow = nb * 32; o.kind = 2; return true; }
    if (r >= P8_D) return false; const int mat = r / 256, q = r % 256, kb = q / 32, nb = q % 32;
    o.W = p.in[I_GWO] + (size_t)mat * D * D; o.WT = ws + WS_WGO + (size_t)mat * D * D; o.Nstride = D; o.Kdst = D; o.k0 = kb * 128; o.n0 = nb * 32; o.drow = nb * 32; o.kind = 1; return true;
}
__device__ __forceinline__ void p8_load(const P8Item& o, f32x4 (&v)[16], int lane) {
#pragma unroll
    for (int i = 0; i < 16; ++i) v[i] = __builtin_nontemporal_load((const f32x4*)(o.W + (size_t)(o.k0 + 8 * i + (lane >> 3)) * o.Nstride + o.n0 + 4 * (lane & 7)));
}
template <int WHICH>
__device__ __forceinline__ void p8_emit(const P8Item& o, const f32x4 (&v)[16], LAS float* scr, int lane) {
#pragma unroll
    for (int i = 0; i < 16; ++i)
#pragma unroll
        for (int e = 0; e < 4; ++e) scr[(8 * i + (lane >> 3)) * 33 + 4 * (lane & 7) + e] = v[i][e];
    LDS_WAIT(); asm volatile("" ::: "memory");
    const int c = lane & 7; const float sc = WHICH == 2 ? 32.f : (WHICH == 1 ? 16.f : (o.n0 < FF ? 32.f * LOG2E : 256.f / LOG2E));
#pragma unroll
    for (int j = 0; j < 4; ++j) { const int n = (lane >> 3) + 8 * j; const LAS float* s = scr + (16 * c) * 33 + n;
        u32x4 w;
        w.x = pk4_fp8(s[0 * 33] * sc, s[1 * 33] * sc, s[2 * 33] * sc, s[3 * 33] * sc); w.y = pk4_fp8(s[4 * 33] * sc, s[5 * 33] * sc, s[6 * 33] * sc, s[7 * 33] * sc);
        w.z = pk4_fp8(s[8 * 33] * sc, s[9 * 33] * sc, s[10 * 33] * sc, s[11 * 33] * sc); w.w = pk4_fp8(s[12 * 33] * sc, s[13 * 33] * sc, s[14 * 33] * sc, s[15 * 33] * sc);
        unsigned char* dp = o.WT + (size_t)(o.drow + n) * o.Kdst;
        *(u32x4*)(dp + o.k0 + 16 * c) = w;
        }
    LDS_WAIT(); asm volatile("" ::: "memory");
}
__device__ __forceinline__ void p0_prologue(const Params& p, LAS unsigned char* lds) {
    int tid = threadIdx.x; asm volatile("" : "+v"(tid));
    const int lane = tid & 63, w = __builtin_amdgcn_readfirstlane(tid >> 6), c = blockIdx.x, G = gridDim.x;
    unsigned char* ws = p.ws;
    for (int item = c; item < 192; item += G) {
        const int l = item / 48, ch = item % 48;
        LAS float* SC = (LAS float*)lds; LAS float* RED = (LAS float*)(lds + 32768);
        __syncthreads();
        for (int idx = tid; idx < NB * D; idx += NTHR) { const int bb = idx >> 10, k = idx & 1023; const float v = p.in[I_C][idx]; SC[k * 8 + bb] = v / (1.0f + __expf(-v)); }
        __syncthreads();
        float a0[8], a1[8];
#pragma unroll
        for (int bb = 0; bb < 8; ++bb) { a0[bb] = 0.f; a1[bb] = 0.f; }
        const float* wp = p.in[I_WMOD] + ((size_t)l * D + 128 * w) * 6144 + ch * 128 + 2 * lane;
#pragma unroll 8
        for (int kk = 0; kk < 128; ++kk) {
            const f32x2 wv = *(const f32x2*)(wp + (size_t)kk * 6144);
            const LAS f32x4* s = (const LAS f32x4*)(SC + (128 * w + kk) * 8);
            const f32x4 sa = s[0], sb = s[1];
            a0[0] += sa[0] * wv[0]; a1[0] += sa[0] * wv[1]; a0[1] += sa[1] * wv[0]; a1[1] += sa[1] * wv[1];
            a0[2] += sa[2] * wv[0]; a1[2] += sa[2] * wv[1]; a0[3] += sa[3] * wv[0]; a1[3] += sa[3] * wv[1];
            a0[4] += sb[0] * wv[0]; a1[4] += sb[0] * wv[1]; a0[5] += sb[1] * wv[0]; a1[5] += sb[1] * wv[1];
            a0[6] += sb[2] * wv[0]; a1[6] += sb[2] * wv[1]; a0[7] += sb[3] * wv[0]; a1[7] += sb[3] * wv[1];
        }
#pragma unroll
        for (int bb = 0; bb < 8; ++bb) { RED[(w * 8 + bb) * 128 + 2 * lane] = a0[bb]; RED[(w * 8 + bb) * 128 + 2 * lane + 1] = a1[bb]; }
        __syncthreads();
        for (int idx = tid; idx < 8 * 128; idx += NTHR) {
            const int bb = idx >> 7, cc = idx & 127; float s = 0.f;
#pragma unroll
            for (int ww = 0; ww < 8; ++ww) s += RED[(ww * 8 + bb) * 128 + cc];
            ((float*)(ws + WS_MOD))[((size_t)(l * NB + bb)) * 6144 + ch * 128 + cc] = s + p.in[I_BMOD][l * 6144 + ch * 128 + cc];
        }
        __syncthreads();
    }
    {
        float* PAR = (float*)(ws + WS_PAR);
        const int idx = c * NTHR + tid;
        if (idx < 8192) PAR[PAR_NG + idx] = p.in[I_NG][idx];
        else if (idx < 8192 + 2048) PAR[PAR_PB + idx - 8192] = p.in[I_PB][idx - 8192];
        else if (idx < 8192 + 4096) PAR[PAR_PS + idx - 10240] = p.in[I_PS][idx - 10240];
        else if (idx < 12288 + 16384) PAR[PAR_GWG + idx - 12288] = p.in[I_GWG][idx - 12288];
        else if (idx < 28672 + 1024) PAR[PAR_GBG + idx - 28672] = p.in[I_GBG][idx - 28672];
        else if (idx < 29696 + 1024) PAR[PAR_FNG + idx - 29696] = p.in[I_FNG][idx - 29696];
        else if (idx < 30720 + 512) PAR[PAR_GNG + idx - 30720] = p.in[I_GNG][idx - 30720];
        else if (idx < 31232 + 32) PAR[PAR_MBG + idx - 31232] = p.in[I_MBG][idx - 31232];
        else if (idx < 31264 + 256) PAR[PAR_MBE + idx - 31264] = p.in[I_MBE][idx - 31264];
    }
    const int gw = c * NWAVES + w, NGW = G * NWAVES;
    for (int it = gw; it < 4 * NRT + 2 * 16; it += NGW) {
        const bool rt = it < 4 * NRT;
        const int r = rt ? it : it - 4 * NRT, set = rt ? r / NRT : r / 16, n = rt ? r % NRT : r % 16, nct = rt ? 5 : 1;
        bf16_t* hi = (bf16_t*)(ws + (rt ? WS_WR : WS_WZ)) + (size_t)(set * 2 + 0) * (rt ? NRT : 16) * D; bf16_t* lo = hi + (size_t)(rt ? NRT : 16) * D;
        float vv[16];
#pragma unroll
        for (int i = 0; i < 16; ++i) { const int k = lane + 64 * i;
            if (rt) vv[i] = n < 8 ? p.in[I_MWG][((size_t)set * D + k) * 8 + n] : (n < 72 ? p.in[I_MWE][((size_t)set * D + k) * 64 + n - 8] : 0.f);
            else vv[i] = p.in[I_GWIN][((size_t)set * D + k) * GIN + NPROJ + n]; }
#pragma unroll
        for (int i = 0; i < 16; ++i) { const int k = lane + 64 * i; const float v = vv[i];
            const int ww = k >> 7, ks = (k >> 5) & 3, q = (k >> 3) & 3, j = k & 7, ct = n >> 4, ln = q * 16 + (n & 15);
            const size_t fo = ((size_t)((ww * 4 + ks) * nct + ct) * 64 + ln) * 8 + j;
            const unsigned h = f2bf(v); hi[fo] = (bf16_t)h; lo[fo] = (bf16_t)f2bf(v - bf2f(h));
        }
    }
    LAS float* scr = (LAS float*)(lds + 65536 + w * 8448);
    __syncthreads();
    {
        P0Item ia, ib, ic; float va[32], vb[32], vc[32];
        int it = gw; bool ha = p0_item(p, it, ia), hb = p0_item(p, it + NGW, ib), hc;
        if (ha) p0_load(ia, va, lane);
        if (hb) p0_load(ib, vb, lane);
        while (ha) {
            hc = p0_item(p, it + 2 * NGW, ic); if (hc) p0_load(ic, vc, lane);
            p0_emit(ia, va, scr, lane);
            if (!hb) break;
            ha = p0_item(p, it + 3 * NGW, ia); if (ha) p0_load(ia, va, lane);
            p0_emit(ib, vb, scr, lane);
            if (!hc) break;
            hb = p0_item(p, it + 4 * NGW, ib); if (hb) p0_load(ib, vb, lane);
            p0_emit(ic, vc, scr, lane);
            it += 3 * NGW;
        }
    }
    __syncthreads();
    {
        LAS float* scr8 = (LAS float*)(lds + w * 16896);
#define P8_RUN(WHICH) do { P8Item ia, ib; f32x4 va[16], vb[16]; int it = gw; bool ha = p8_item<WHICH>(p, it, ia), hb; if (ha) p8_load(ia, va, lane); \
        while (ha) { hb = p8_item<WHICH>(p, it + NGW, ib); if (hb) p8_load(ib, vb, lane); p8_emit<WHICH>(ia, va, scr8, lane); if (!hb) break; \
                     it += 2 * NGW; ha = p8_item<WHICH>(p, it, ia); if (ha) p8_load(ia, va, lane); p8_emit<WHICH>(ib, vb, scr8, lane); } } while (0)
        if (P8_A) P8_RUN(0);
        if (P8_B) P8_RUN(1);
        if (P8_D) P8_RUN(2);
#undef P8_RUN
        __syncthreads();
    }
}

constexpr int PH_FINAL = 41, PH_END = 42;
__global__ void __launch_bounds__(NTHR, 2) mk_fwd(Params p) {
    extern __shared__ __attribute__((aligned(16))) unsigned char lds_raw[];
    LAS unsigned char* lds = (LAS unsigned char*)lds_raw;
    const int tid = threadIdx.x, G = gridDim.x, c = blockIdx.x;
    unsigned char* ws = p.ws;
    __builtin_amdgcn_s_setreg((0 << 11) | (23 << 6) | 1, 1);
    if (tid < 64) ((LAS unsigned*)(lds + L_MISC))[tid] = 0u;
    __syncthreads();
    XcdBarrier bar; bar.bar = (unsigned*)(ws + WS_CTL) + CW_BAR; bar.x = 0; bar.st = nullptr;
    if (p.use_bar) bar = xcd_barrier_post((unsigned*)(ws + WS_CTL) + CW_BAR, (volatile LAS unsigned*)(lds + L_MISC));
#ifndef PHMASK
#define PHMASK 0xFFFF
#endif
#define EN(bit) ((PHMASK >> (bit)) & 1)
#ifndef DUPMASK
#define DUPMASK 0
#endif
#define DUP(bit) ((DUPMASK >> (bit)) & 1)
#define RUN(pid) (p.ph_lo <= (pid) && (pid) < p.ph_hi)
#define SEAMT(ty) do { if (p.use_bar) xcd_barrier(bar); } while (0)


    if (EN(0) && RUN(0)) { p0_prologue(p, lds); SEAMT(0); if (DUP(0)) { p0_prologue(p, lds); SEAMT(0); } }

    for (int layer = 0; layer < DEPTH; ++layer) {
        const int base = 1 + 10 * layer, j2 = layer >> 1; const bool pool = (layer & 1) == 0;
        if (EN(1) && RUN(base + 0)) { if (layer == 0) token_phase<0, true>(p, lds, layer); else if (pool) token_phase<0, false>(p, lds, layer); else token_phase<1, false>(p, lds, layer); SEAMT(1);
            if (DUP(1)) { if (layer == 0) token_phase<0, true>(p, lds, layer, true); else if (pool) token_phase<0, false>(p, lds, layer, true); else token_phase<1, false>(p, lds, layer, true); SEAMT(1); } }
        if (pool) {
            if (EN(2) && RUN(base + 1)) {
#if FUSE_RES
                pg8::ResidEpi<pg8::PlainGemm, true> g; g.A = (const bf16_t*)(ws + WS_H); g.Bt = (const bf16_t*)(ws + WS_WPL) + (size_t)j2 * D * 256; g.O = nullptr; g.N = D; g.K = 256; g.lda = D; g.ldc = D; g.acol = 256; g.G = G; g.c = c;
                g.Xin = (const bf16_t*)(ws + WS_X2); g.Xout = (bf16_t*)(ws + WS_X); g.g1 = (const float*)(ws + WS_MOD) + (size_t)layer * NB * 6144 + 2048; g.ps = (const float*)(ws + WS_PAR) + PAR_PS + j2 * D; g.pb = (const float*)(ws + WS_PAR) + PAR_PB + j2 * D;
#else
                pg8::PlainGemm g{(const bf16_t*)(ws + WS_H), (const bf16_t*)(ws + WS_WPL) + (size_t)j2 * D * 256, (bf16_t*)(ws + WS_U), D, 256, D, D, 256, G, c};
#endif
                pg8::gemm_phase(lds + L_STAGE, lds + L_IDX, g); SEAMT(2); if (DUP(2)) { pg8::gemm_phase(lds + L_STAGE, lds + L_IDX, g); SEAMT(2); } }
        } else {
            if (EN(3) && RUN(base + 1)) {
#if G2_FP8
                pg8::PlainGemmF8<0x7A7A7A7A> g; g.A = (const bf16_t*)(ws + WS_H); g.Bt = (const bf16_t*)(ws + WS_WGI + (size_t)j2 * NPROJ * D); g.O = (bf16_t*)(ws + WS_PROJ); g.N = NPROJ; g.K = D / 2; g.lda = D / 2; g.ldc = NPROJ; g.acol = 0; g.G = G; g.c = c;
#else
#if G2_VR8
                pg8::PlainGemm g{(const bf16_t*)(ws + WS_H), (const bf16_t*)(ws + WS_WGI + (size_t)j2 * 2 * MiB), (bf16_t*)(ws + WS_PROJ), 1024, D, D, NPROJ, 0, G, c};
                pg8::PlainGemmF8<0x7A7A7A7A> g8; g8.A = (const bf16_t*)(ws + WS_U + 32 * MiB); g8.Bt = (const bf16_t*)(ws + WS_WGI + 4 * MiB + (size_t)j2 * 2 * MiB); g8.O = (bf16_t*)(ws + WS_PROJ) + 1024; g8.N = 2048; g8.K = D / 2; g8.lda = D / 2; g8.ldc = NPROJ; g8.acol = 0; g8.G = G; g8.c = c;
                pg8::gemm_phase(lds + L_STAGE, lds + L_IDX, g8);
#else
                pg8::PlainGemm g{(const bf16_t*)(ws + WS_H), (const bf16_t*)(ws + WS_WGI) + (size_t)j2 * NPROJ * D, (bf16_t*)(ws + WS_PROJ), NPROJ, D, D, NPROJ, 0, G, c};
#endif
#endif
                pg8::gemm_phase(lds + L_STAGE, lds + L_IDX, g); SEAMT(3); if (DUP(3)) { pg8::gemm_phase(lds + L_STAGE, lds + L_IDX, g); SEAMT(3); } }
            if (EN(4) && RUN(base + 2)) { gla_g3a(p, lds, layer); SEAMT(4); if (DUP(4)) { gla_g3a(p, lds, layer); SEAMT(4); } }
            if (EN(5) && RUN(base + 3)) { gla_g3b(p, lds, layer); SEAMT(5); if (DUP(5)) { gla_g3b(p, lds, layer); SEAMT(5); } }
            if (!FUSE_G4 && EN(6) && RUN(base + 4)) { gla_g4(p, layer); SEAMT(6); if (DUP(6)) { gla_g4(p, layer); SEAMT(6); } }
            if (EN(7) && RUN(base + 5)) {
#if FUSE_G4
#if FUSE_RES
#if G5_FP8
                pg8::ResidEpi<pg8::HeadScaleGemmF8, false> g;
#else
                pg8::ResidEpi<pg8::HeadScaleGemm, false> g;
#endif
                g.Xin = (const bf16_t*)(ws + WS_X2); g.Xout = (bf16_t*)(ws + WS_X); g.g1 = (const float*)(ws + WS_MOD) + (size_t)layer * NB * 6144 + 2048; g.ps = nullptr; g.pb = nullptr;
#else
                pg8::HeadScaleGemm g;
#endif
                g.A = (const bf16_t*)(ws + WS_A); g.Bt = (const bf16_t*)(ws + WS_WGO + (size_t)j2 * D * D * (G5_FP8 ? 1 : 2)); g.O = (bf16_t*)(ws + WS_U); g.N = D; g.K = G5_FP8 ? D / 2 : D; g.lda = g.K; g.ldc = D; g.acol = 0; g.G = G; g.c = c;
                g.tab = (const LAS float*)(lds + L_IDX);
                __syncthreads();
                {
                    int tq = threadIdx.x; asm volatile("" : "+v"(tq));
                    pg8::Unit u; const int i = tq >> 8, row = tq & 255;
                    if (g.unit(i, u)) {
                        const float* sp = (const float*)(ws + WS_O) + (size_t)(u.pm * 256 + row);
                        float rs[4];
#pragma unroll
                        for (int h = 0; h < 4; ++h) { float a[8];
#pragma unroll
                            for (int q = 0; q < 8; ++q) a[q] = sp[(size_t)(h * 8 + q) * T];
                            rs[h] = 1.0f / sqrtf(((a[0] + a[1]) + (a[2] + a[3]) + (a[4] + a[5]) + (a[6] + a[7])) * (1.0f / HV) + EPS); }
                        LAS float* tb = (LAS float*)(lds + L_IDX) + i * 1024 + row;
                        tb[0] = rs[0] / rs[1]; tb[256] = rs[1] / rs[2]; tb[512] = rs[2] / rs[3]; tb[768] = rs[3];
                    }
                }
                __syncthreads();
                pg8::gemm_phase(lds + L_STAGE, lds + L_IDX, g); SEAMT(7); if (DUP(7)) { pg8::gemm_phase(lds + L_STAGE, lds + L_IDX, g); SEAMT(7); } }
#else
#if G5_FP8
                pg8::ResidEpi<pg8::PlainGemmF8<0x7A7A7A7A>, false> g; g.A = (const bf16_t*)(ws + WS_A); g.Bt = (const bf16_t*)(ws + WS_WGO + (size_t)j2 * D * D); g.O = nullptr; g.N = D; g.K = D / 2; g.lda = D / 2; g.ldc = D; g.acol = 0; g.G = G; g.c = c;
#else
                pg8::ResidEpi<pg8::PlainGemm, false> g; g.A = (const bf16_t*)(ws + WS_A); g.Bt = (const bf16_t*)(ws + WS_WGO) + (size_t)j2 * D * D; g.O = nullptr; g.N = D; g.K = D; g.lda = D; g.ldc = D; g.acol = 0; g.G = G; g.c = c;
#endif
                g.Xin = (const bf16_t*)(ws + WS_X2); g.Xout = (bf16_t*)(ws + WS_X); g.g1 = (const float*)(ws + WS_MOD) + (size_t)layer * NB * 6144 + 2048; g.ps = nullptr; g.pb = nullptr;
                pg8::gemm_phase(lds + L_STAGE, lds + L_IDX, g); SEAMT(7); if (DUP(7)) { pg8::gemm_phase(lds + L_STAGE, lds + L_IDX, g); SEAMT(7); } }
#endif
        }
        if (EN(8) && RUN(base + 6)) { token_phase<2, false>(p, lds, layer); SEAMT(8); if (DUP(8)) { token_phase<2, false>(p, lds, layer, true); SEAMT(8); } }
        if (EN(9) && RUN(base + 7)) {
            moe_build_units(lds, (unsigned*)(ws + WS_CTL) + CW_CNT + layer * 64 * 16, G, c);
            pg8::Moe1 g; g.ut = (const LAS int*)(lds + L_UT); g.list = ws + WS_LIST; g.H = (const bf16_t*)(ws + (M1_FP8 ? WS_U : WS_H)); g.W = (const bf16_t*)(ws + WS_WMI + (size_t)layer * NE * 768 * D * (M1_FP8 ? 1 : 2)); g.ACT = (bf16_t*)(ws + WS_ACT); g.K = M1_FP8 ? D / 2 : D; g.lda = g.K;
            pg8::gemm_phase(lds + L_STAGE, lds + L_IDX, g); SEAMT(9); if (DUP(9)) { pg8::gemm_phase(lds + L_STAGE, lds + L_IDX, g); SEAMT(9); } }
        if (EN(10) && RUN(base + 8)) {
            pg8::Moe2 g; g.ut = (const LAS int*)(lds + L_UT2); g.list = ws + WS_LIST; g.ACT = (const bf16_t*)(ws + WS_ACT); g.W = (const bf16_t*)(ws + WS_WMO + (size_t)layer * NE * D * (M2_FP8 ? 512 : FF * 2)); g.Y = (bf16_t*)(ws + WS_Y); g.K = M2_FP8 ? 256 : FF; g.lda = g.K;
            pg8::gemm_phase(lds + L_STAGE, lds + L_IDX, g); SEAMT(10); if (DUP(10)) { pg8::gemm_phase(lds + L_STAGE, lds + L_IDX, g); SEAMT(10); } }
    }
    if (EN(11) && RUN(PH_FINAL)) { token_phase<3, false>(p, lds, 3); if (DUP(11)) { SEAMT(11); token_phase<3, false>(p, lds, 3, true); } }
#undef RUN
#undef SEAM
}

extern "C" void kernel_launch(void* const* d_in, const int* in_sizes, int n_in, void* d_out, int out_size, void* d_ws, size_t ws_size, hipStream_t stream) {
    static int grid = 0;
    if (grid == 0) {
        if (n_in != 20 || out_size != T * D || ws_size < WS_END2 + (DUPMASK ? (size_t)1040 * MiB : 0)) { fprintf(stderr, "kernel_launch: unexpected shapes (n_in %d out %d ws %zu)\n", n_in, out_size, ws_size); grid = -1; return; }
        int dev = 0, cus = 0, per_cu = 0;
        (void)hipGetDevice(&dev); (void)hipDeviceGetAttribute(&cus, hipDeviceAttributeMultiprocessorCount, dev);
        if (hipFuncSetAttribute((const void*)mk_fwd, hipFuncAttributeMaxDynamicSharedMemorySize, LDS_BYTES) != hipSuccess) { fprintf(stderr, "kernel_launch: hipFuncSetAttribute failed\n"); grid = -1; return; }
        (void)hipOccupancyMaxActiveBlocksPerMultiprocessor(&per_cu, (const void*)mk_fwd, NTHR, LDS_BYTES);
        (void)hipGetLastError();
        if (cus != 256 || per_cu < 1) fprintf(stderr, "kernel_launch: note: %d CUs, occupancy query %d (built for 256 CUs, one workgroup each)\n", cus, per_cu);
        grid = 256;
    }
    if (grid < 0) return;
    (void)hipMemsetAsync((char*)d_ws + WS_CTL, 0, CTL_ZERO_BYTES, stream);
    Params a{};
    for (int i = 0; i < 20; ++i) a.in[i] = (const float*)d_in[i];
    a.out = (float*)d_out; a.ws = (unsigned char*)d_ws; a.pad = 0;
#if MK_ONE_LAUNCH
    a.ph_lo = 0; a.ph_hi = PH_END; a.use_bar = 1;
    hipLaunchKernelGGL(mk_fwd, dim3(grid), dim3(NTHR), LDS_BYTES, stream, a);
#else
    a.use_bar = 0;
    for (int pid = 0; pid < PH_END; ++pid) {
        bool active = (pid == 0 || pid == PH_FINAL);
        if (pid >= 1 && pid < PH_FINAL) { const int L = (pid - 1) / 10, k = (pid - 1) % 10; const bool pool = (L & 1) == 0;
            active = (k == 0 || k == 6 || k == 7 || k == 8) || (pool ? (k == 1) : (k >= 1 && k <= 5)); }
        if (!active) continue;
        a.ph_lo = pid; a.ph_hi = pid + 1;
        hipLaunchKernelGGL(mk_fwd, dim3(grid), dim3(NTHR), LDS_BYTES, stream, a);
    }
#endif
}
```
